# Optimizing an MI355X kernel written in HIP

```python
import math
import jax, jax.numpy as jnp
from jax import lax
import numpy as np

D_MODEL = 1024
BATCH = 4
SEQ = 8192
DEPTH = 1

HEAD_DIM = 128
MOBA_HEADS = 6
MOBA_BLOCK = 256
MOBA_TOPK = 3
MOBA_QCHUNK = 32
GMLP_GROUPS = 6
GMLP_GROUP_DIM = 128
GMLP_CHUNK = 128
XATTN_HEADS = 4
MEM_LEN = 256
ROPE_THETA = 500000.0
ROT_DIM = HEAD_DIM // 4
EPS = 1e-6

A_WIDTH = MOBA_HEADS * HEAD_DIM
B_WIDTH = GMLP_GROUPS * GMLP_GROUP_DIM
C_WIDTH = XATTN_HEADS * HEAD_DIM
IN_SPLITS = (A_WIDTH, A_WIDTH, A_WIDTH, A_WIDTH, B_WIDTH, B_WIDTH, B_WIDTH, C_WIDTH, C_WIDTH, D_MODEL, D_MODEL, D_MODEL)
IN_WIDTH = 4 * A_WIDTH + 3 * B_WIDTH + 2 * C_WIDTH + 3 * D_MODEL

kernel_name = "hybrid_moba_gmlp_xattn_gated_layer"


def rms_norm(x, g):
    xf = x.astype(jnp.float32)
    y = xf * lax.rsqrt(jnp.mean(xf * xf, axis=-1, keepdims=True) + EPS)
    return (y * g.astype(jnp.float32)).astype(x.dtype)


def layer_norm(x, g):
    xf = x.astype(jnp.float32)
    mu = jnp.mean(xf, axis=-1, keepdims=True)
    var = jnp.mean(jnp.square(xf - mu), axis=-1, keepdims=True)
    return ((xf - mu) * lax.rsqrt(var + EPS) * g.astype(jnp.float32)).astype(x.dtype)


def split_cols(t, widths):
    offs, acc = [], 0
    for w in widths[:-1]:
        acc += w
        offs.append(acc)
    return jnp.split(t, offs, axis=-1)


def partial_rope(x, pos):
    half = ROT_DIM // 2
    inv_freq = ROPE_THETA ** (-jnp.arange(0, ROT_DIM, 2, dtype=jnp.float32) / ROT_DIM)
    ang = pos.astype(jnp.float32)[:, None] * inv_freq[None, :]
    cos = jnp.cos(ang)[None, :, None, :].astype(x.dtype)
    sin = jnp.sin(ang)[None, :, None, :].astype(x.dtype)
    x1, x2, rest = x[..., :half], x[..., half:ROT_DIM], x[..., ROT_DIM:]
    return jnp.concatenate([x1 * cos - x2 * sin, x2 * cos + x1 * sin, rest], axis=-1)


def moba_attention(q, k, v):
    B, S, H, dh = q.shape
    n_blocks = -(-S // MOBA_BLOCK)
    k_sel_n = min(MOBA_TOPK, n_blocks)
    pad = n_blocks * MOBA_BLOCK - S
    scale = HEAD_DIM ** -0.5
    qh = jnp.transpose(q, (0, 2, 1, 3))
    kh = jnp.pad(jnp.transpose(k, (0, 2, 1, 3)), ((0, 0), (0, 0), (0, pad), (0, 0)))
    vh = jnp.pad(jnp.transpose(v, (0, 2, 1, 3)), ((0, 0), (0, 0), (0, pad), (0, 0)))
    k_blk = kh.reshape(B, H, n_blocks, MOBA_BLOCK, dh)
    v_blk = vh.reshape(B, H, n_blocks, MOBA_BLOCK, dh)
    k_mean = jnp.mean(k_blk.astype(jnp.float32), axis=3)
    b_ix = jnp.arange(B)[:, None, None, None]
    h_ix = jnp.arange(H)[None, :, None, None]
    blk_ids = jnp.arange(n_blocks)

    def chunk_fn(c):
        start = c * MOBA_QCHUNK
        qc = lax.dynamic_slice_in_dim(qh, start, MOBA_QCHUNK, axis=2)
        pos_q = start + jnp.arange(MOBA_QCHUNK)
        own = start // MOBA_BLOCK
        bs = jnp.einsum('bhqd,bhnd->bhqn', qc.astype(jnp.float32), k_mean)
        bs = jnp.where((blk_ids < own)[None, None, None, :], bs, -jnp.inf)
        _, sel_idx = lax.top_k(bs, k_sel_n)
        sel_valid = sel_idx < own
        k_sel = k_blk[b_ix, h_ix, sel_idx]
        v_sel = v_blk[b_ix, h_ix, sel_idx]
        lg_sel = jnp.einsum('bhqd,bhqkpd->bhqkp', qc, k_sel).astype(jnp.float32) * scale
        lg_sel = jnp.where(sel_valid[..., None], lg_sel, -jnp.inf)
        lg_sel = lg_sel.reshape(B, H, MOBA_QCHUNK, k_sel_n * MOBA_BLOCK)
        k_own = lax.dynamic_index_in_dim(k_blk, own, axis=2, keepdims=False)
        v_own = lax.dynamic_index_in_dim(v_blk, own, axis=2, keepdims=False)
        key_pos = own * MOBA_BLOCK + jnp.arange(MOBA_BLOCK)
        causal = key_pos[None, :] <= pos_q[:, None]
        lg_own = jnp.einsum('bhqd,bhpd->bhqp', qc, k_own).astype(jnp.float32) * scale
        lg_own = jnp.where(causal[None, None], lg_own, -jnp.inf)
        p = jax.nn.softmax(jnp.concatenate([lg_sel, lg_own], axis=-1), axis=-1).astype(v.dtype)
        p_sel = p[..., :k_sel_n * MOBA_BLOCK].reshape(B, H, MOBA_QCHUNK, k_sel_n, MOBA_BLOCK)
        p_own = p[..., k_sel_n * MOBA_BLOCK:]
        return (jnp.einsum('bhqkp,bhqkpd->bhqd', p_sel, v_sel)
                + jnp.einsum('bhqp,bhpd->bhqd', p_own, v_own))

    out = lax.map(chunk_fn, jnp.arange(S // MOBA_QCHUNK))
    return jnp.transpose(out, (1, 0, 3, 2, 4)).reshape(B, S, H * dh)


def gmlp_spatial_gate(u, v, ln_g, w_spatial, b_spatial):
    B, S, _ = v.shape
    vn = layer_norm(v, ln_g).reshape(B, S // GMLP_CHUNK, GMLP_CHUNK, GMLP_GROUPS, GMLP_GROUP_DIM)
    w_causal = jnp.tril(w_spatial)
    mixed = jnp.einsum('gts,bnsgd->bntgd', w_causal, vn) + jnp.transpose(b_spatial)[None, None, :, :, None]
    return u * mixed.reshape(B, S, B_WIDTH)


def memory_cross_attention(q, mem_n, w_mem_kv):
    B, S, _ = q.shape
    M = mem_n.shape[1]
    mk, mv = jnp.split(mem_n @ w_mem_kv, 2, axis=-1)
    qh = q.reshape(B, S, XATTN_HEADS, HEAD_DIM)
    kh = mk.reshape(B, M, XATTN_HEADS, HEAD_DIM)
    vh = mv.reshape(B, M, XATTN_HEADS, HEAD_DIM)
    lg = jnp.einsum('bshd,bmhd->bhsm', qh, kh).astype(jnp.float32) * (HEAD_DIM ** -0.5)
    p = jax.nn.softmax(lg, axis=-1).astype(q.dtype)
    return jnp.einsum('bhsm,bmhd->bshd', p, vh).reshape(B, S, C_WIDTH)


def setup_inputs(seed: int = 0) -> dict:
    key = jax.random.key(seed)
    ks = jax.random.split(key, 16)
    f32 = jnp.float32

    def nrm(k, shape, fan_in):
        return jax.random.normal(k, shape, f32) * (fan_in ** -0.5)

    def gain(k, shape):
        return 1.0 + 0.1 * jax.random.normal(k, shape, f32)

    return {
        "x": jax.random.normal(ks[0], (BATCH, SEQ, D_MODEL), f32),
        "mem": jax.random.normal(ks[1], (BATCH, MEM_LEN, D_MODEL), f32),
        "norm_g": gain(ks[2], (DEPTH, D_MODEL)),
        "mem_norm_g": gain(ks[3], (DEPTH, D_MODEL)),
        "final_norm_g": gain(ks[4], (D_MODEL,)),
        "w_in": nrm(ks[5], (DEPTH, D_MODEL, IN_WIDTH), D_MODEL),
        "w_mem_kv": nrm(ks[6], (DEPTH, D_MODEL, 2 * C_WIDTH), D_MODEL),
        "gmlp_ln_g": gain(ks[7], (DEPTH, B_WIDTH)),
        "w_spatial": nrm(ks[8], (DEPTH, GMLP_GROUPS, GMLP_CHUNK, GMLP_CHUNK), GMLP_CHUNK),
        "b_spatial": gain(ks[9], (DEPTH, GMLP_GROUPS, GMLP_CHUNK)),
        "w_branch_a": nrm(ks[10], (DEPTH, A_WIDTH, D_MODEL), A_WIDTH),
        "w_branch_b": nrm(ks[11], (DEPTH, B_WIDTH, D_MODEL), B_WIDTH),
        "w_branch_c": nrm(ks[12], (DEPTH, C_WIDTH, D_MODEL), C_WIDTH),
        "w_out": nrm(ks[13], (DEPTH, D_MODEL, D_MODEL), D_MODEL),
    }


def reference(x, mem, norm_g, mem_norm_g, final_norm_g, w_in, w_mem_kv, gmlp_ln_g,
              w_spatial, b_spatial, w_branch_a, w_branch_b, w_branch_c, w_out):
    B, S, _ = x.shape
    pos = jnp.arange(S)
    for layer in range(DEPTH):
        h = rms_norm(x, norm_g[layer])
        (qa, ka, va, ga, ub, vb, gb, qc, gc, ma, mb, mc) = split_cols(h @ w_in[layer], IN_SPLITS)
        qa = partial_rope(qa.reshape(B, S, MOBA_HEADS, HEAD_DIM), pos)
        ka = partial_rope(ka.reshape(B, S, MOBA_HEADS, HEAD_DIM), pos)
        va = va.reshape(B, S, MOBA_HEADS, HEAD_DIM)
        out_a = moba_attention(qa, ka, va) * jax.nn.silu(ga)
        out_b = gmlp_spatial_gate(ub, vb, gmlp_ln_g[layer], w_spatial[layer], b_spatial[layer]) * jax.nn.silu(gb)
        mem_n = rms_norm(mem, mem_norm_g[layer])
        out_c = memory_cross_attention(qc, mem_n, w_mem_kv[layer]) * jax.nn.silu(gc)
        y = (jax.nn.sigmoid(ma) * (out_a @ w_branch_a[layer])
             + jax.nn.sigmoid(mb) * (out_b @ w_branch_b[layer])
             + jax.nn.sigmoid(mc) * (out_c @ w_branch_c[layer]))
        x = x + y @ w_out[layer]
    return rms_norm(x, final_norm_g)
```

```cpp
#include <hip/hip_runtime.h>
#include <hip/hip_cooperative_groups.h>
#include <cstdio>
#include <cstdint>
namespace cg = cooperative_groups;

#define LAS __attribute__((address_space(3)))
#define DI __device__ __forceinline__

typedef unsigned short bf16_t;
typedef short bf16x8 __attribute__((ext_vector_type(8)));
typedef float f32x2 __attribute__((ext_vector_type(2)));
typedef float f32x4 __attribute__((ext_vector_type(4)));
typedef float f32x16 __attribute__((ext_vector_type(16)));
typedef __bf16 bf16x2_t __attribute__((ext_vector_type(2)));
typedef unsigned u32x2 __attribute__((ext_vector_type(2)));
typedef unsigned u32x4 __attribute__((ext_vector_type(4)));

#define REP0 1
#define REP1 1
#define REP2 1
#define REP2G 1
#define REP3 1
#define REP4 1
#define REP5 1
constexpr int DM = 1024, NB = 4, SEQ = 8192, MTOK = NB * SEQ;
constexpr int AW = 768, CW = 512, INW = 9472;
constexpr int NTHREADS = 512;
constexpr int LDS_BYTES = 152 * 1024;

constexpr size_t MiB = 1u << 20;
constexpr size_t OFF_ROWSS = 0;
constexpr size_t OFF_KMEAN = 131072;
constexpr size_t OFF_KMAX2 = 524288;
constexpr size_t OFF_MKMAX2 = 528384;
constexpr size_t OFF_BAR = 528384 + 1024;
constexpr size_t OFF_GCNT = 528384 + 2048;
constexpr size_t OFF_C5 = 528384 + 2048 + 3072;
constexpr size_t OFF_ROPE = 1 * MiB;
constexpr size_t OFF_HB = 2 * MiB;
constexpr size_t OFF_WIN = 66 * MiB;
constexpr size_t OFF_WMKV = OFF_WIN + (size_t)INW * 1024 * 2;
constexpr size_t OFF_WA = OFF_WMKV + 2 * MiB;
constexpr size_t OFF_WB = OFF_WA + 1536 * 1024;
constexpr size_t OFF_WC = OFF_WB + 1536 * 1024;
constexpr size_t OFF_WO = OFF_WC + 1 * MiB;
constexpr size_t OFF_MEMN = OFF_WO + 2 * MiB;
constexpr size_t OFF_MEMK = OFF_MEMN + 2 * MiB;
constexpr size_t OFF_MEMVT = OFF_MEMK + 1 * MiB;
constexpr size_t OFF_REG = 97 * MiB;
constexpr size_t OFF_Q = OFF_REG;
constexpr size_t OFF_K = OFF_REG + 48 * MiB;
constexpr size_t OFF_VT = OFF_REG + 96 * MiB;
constexpr size_t OFF_VBT = OFF_REG + 144 * MiB;
constexpr size_t OFF_GB = OFF_REG + 192 * MiB;
constexpr size_t OFF_QC = OFF_REG + 240 * MiB;
constexpr size_t OFF_GA = OFF_REG + 272 * MiB;
constexpr size_t OFF_UB = OFF_REG + 320 * MiB;
constexpr size_t OFF_GC = OFF_REG + 368 * MiB;
constexpr size_t WS_END = OFF_REG + 400 * MiB;
constexpr size_t OFF_GLIST = OFF_WIN;
constexpr size_t WS_END2 = WS_END;
static_assert(12 * MiB <= (size_t)6400 * 1024 * 2, "query lists must fit the dead part of the input-projection weights");
constexpr size_t OFF_PO01 = OFF_VBT, OFF_PO2 = OFF_UB;
constexpr size_t OFF_PL01 = OFF_WMKV, OFF_PL23 = OFF_MEMN;
constexpr size_t OFF_PL4 = WS_END2; constexpr size_t WS_END3 = WS_END2 + 3 * MiB;
constexpr size_t OFF_TA = OFF_REG;
constexpr size_t OFF_TB = OFF_REG + 64 * MiB;
constexpr size_t OFF_TC = OFF_REG + 128 * MiB;
constexpr size_t OFF_Y = OFF_REG + 192 * MiB;
static_assert(OFF_MEMVT + 1 * MiB <= OFF_REG, "ws map");
constexpr size_t DO_OA = 0, DO_OC = 48 * MiB, DO_OB = 80 * MiB;

struct Params {
  const float *x, *mem, *norm_g, *mem_norm_g, *final_g, *w_in, *w_mkv, *ln_g, *w_sp, *b_sp, *w_a, *w_b, *w_c, *w_out;
  float* out; char* ws;
};

DI unsigned pk2(float lo, float hi) { f32x2 v = {lo, hi}; return __builtin_bit_cast(unsigned, __builtin_convertvector(v, bf16x2_t)); }
DI float bf_lo(unsigned u) { return __uint_as_float(u << 16); }
DI float bf_hi(unsigned u) { return __uint_as_float(u & 0xffff0000u); }
DI float wave_sum(float v) {
#pragma unroll
  for (int o = 1; o < 64; o <<= 1) v += __shfl_xor(v, o);
  return v;
}
DI float wave_max(float v) {
#pragma unroll
  for (int o = 1; o < 64; o <<= 1) v = fmaxf(v, __shfl_xor(v, o));
  return v;
}
DI float silu_f(float v) { return v * __builtin_amdgcn_rcpf(1.f + __expf(-v)); }
DI float sigmoid_f(float v) { return __builtin_amdgcn_rcpf(1.f + __expf(-v)); }
DI f32x16 mfma32(bf16x8 a, bf16x8 b, f32x16 c) { return __builtin_amdgcn_mfma_f32_32x32x16_bf16(a, b, c, 0, 0, 0); }
DI int crow(int i, int hh) { return (i & 3) + 8 * (i >> 2) + 4 * hh; }
DI int launder(int v) { asm volatile("" : "+v"(v)); return v; }
DI int make_tid(const int wv) { int l; asm volatile("v_mbcnt_lo_u32_b32 %0, -1, 0\n\tv_mbcnt_hi_u32_b32 %0, -1, %0" : "=v"(l)); return wv * 64 + l; }
DI void lds_wait() { asm volatile("s_waitcnt lgkmcnt(0)" ::: "memory"); }

DI void grid_bar(unsigned* ctr, unsigned k, const int tid) {
  __syncthreads();
  if (tid == 0) {
    const unsigned g = blockIdx.x & 7u, gsz = (gridDim.x - g + 7u) >> 3, ngrp = gridDim.x < 8u ? gridDim.x : 8u;
    __builtin_amdgcn_fence(__ATOMIC_RELEASE, "agent");
    const unsigned old = __hip_atomic_fetch_add(ctr + 16 + 16 * g, 1u, __ATOMIC_RELAXED, __HIP_MEMORY_SCOPE_AGENT);
    if (old + 1u == gsz * k) __hip_atomic_fetch_add(ctr, 1u, __ATOMIC_RELAXED, __HIP_MEMORY_SCOPE_AGENT);
    while (__hip_atomic_load(ctr, __ATOMIC_RELAXED, __HIP_MEMORY_SCOPE_AGENT) < ngrp * k) __builtin_amdgcn_s_sleep(2);
    __builtin_amdgcn_fence(__ATOMIC_ACQUIRE, "agent");
  }
  __syncthreads();
}

constexpr int BK = 64, HALF = 128, HTB = HALF * BK * 2;
DI int lds_byte(int r, int c) { int st = (r >> 4) * 2 + (c >> 5), rr = r & 15, cc = c & 31, ob = rr * 64 + cc * 2; return st * 1024 + (ob ^ (((ob >> 9) & 1) << 5)); }
DI void stage_rc(int b, int& R, int& C) { int st = b / 1024, sb = b % 1024, swz = sb ^ (((sb >> 9) & 1) << 5); R = (st >> 1) * 16 + swz / 64; C = (st & 1) * 32 + (swz % 64) / 2; }

DI void gemm_tile(const int tid, const bf16_t* A, const bf16_t* Bm, const int ld, int K, LAS char* lds, f32x4 (&acc)[2][2][4][2]) {
  const int wid = __builtin_amdgcn_readfirstlane(tid >> 6), lane = tid & 63, wr = wid >> 2, wc = wid & 3, fr = lane & 15, fq = lane >> 4;
  unsigned voffA[2];
#pragma unroll
  for (int i = 0; i < 2; ++i) { int R, C; stage_rc(tid * 16 + i * 8192, R, C); voffA[i] = (unsigned)(R * ld + C) * 2u; }
#define voffB voffA
  const unsigned ldsw = (unsigned)wid * 1024u;
  const int aoff = lds_byte(wr * 64 + fr, fq * 8), boff = lds_byte(wc * 32 + fr, fq * 8);
  const char* cA0 = (const char*)A; const char* cA1 = cA0 + (size_t)HALF * ld * 2;
  const char* cB0 = (const char*)Bm; const char* cB1 = cB0 + (size_t)HALF * ld * 2;
#define G_SA(b, h) (((b) * 2 + (h)) * HTB)
#define G_SB(b, h) ((4 + (b) * 2 + (h)) * HTB)
#define G_STAGE(bufoff, gbase, voff, kt) do { _Pragma("unroll") for (int _i = 0; _i < 2; ++_i) \
    __builtin_amdgcn_global_load_lds((const unsigned*)((gbase) + (size_t)(kt) * (BK * 2) + (voff)[_i]), (LAS unsigned*)(lds + (bufoff) + ldsw + _i * 8192), 16, 0, 0); } while (0)
#define G_LDA(dst, b, h) do { _Pragma("unroll") for (int m = 0; m < 4; ++m) _Pragma("unroll") for (int k = 0; k < 2; ++k) dst[m][k] = *(const LAS bf16x8*)(lds + G_SA(b, h) + aoff + m * 2048 + k * 1024); } while (0)
#define G_LDB(dst, b, h) do { _Pragma("unroll") for (int n = 0; n < 2; ++n) _Pragma("unroll") for (int k = 0; k < 2; ++k) dst[n][k] = *(const LAS bf16x8*)(lds + G_SB(b, h) + boff + n * 2048 + k * 1024); } while (0)
#define G_MMA(ai, bj, At, Bt) do { __builtin_amdgcn_s_setprio(1); _Pragma("unroll") for (int m = 0; m < 4; ++m) _Pragma("unroll") for (int n = 0; n < 2; ++n) _Pragma("unroll") for (int k = 0; k < 2; ++k) \
    acc[ai][bj][m][n] = __builtin_amdgcn_mfma_f32_16x16x32_bf16(At[m][k], Bt[n][k], acc[ai][bj][m][n], 0, 0, 0); __builtin_amdgcn_s_setprio(0); } while (0)
#define G_WAIT_V(n) asm volatile("s_waitcnt vmcnt(" #n ")" ::: "memory")
#define G_WAIT_L(n) asm volatile("s_waitcnt lgkmcnt(" #n ")" ::: "memory")
#define G_BAR __builtin_amdgcn_s_barrier()
#define G_SCHED __builtin_amdgcn_sched_barrier(0)
#pragma unroll
  for (int a = 0; a < 2; ++a)
#pragma unroll
    for (int b = 0; b < 2; ++b)
#pragma unroll
      for (int m = 0; m < 4; ++m)
#pragma unroll
        for (int n = 0; n < 2; ++n) acc[a][b][m][n] = (f32x4){0.f, 0.f, 0.f, 0.f};
  bf16x8 At[4][2], B0[2][2], B1[2][2];
  const int nt = K / BK;
  G_WAIT_V(0); G_WAIT_L(0); __syncthreads();
  G_STAGE(G_SB(0, 0), cB0, voffB, 0); G_STAGE(G_SA(0, 0), cA0, voffA, 0);
  G_STAGE(G_SB(0, 1), cB1, voffB, 0); G_STAGE(G_SA(0, 1), cA1, voffA, 0);
  if (wr == 1) G_BAR;
  G_WAIT_V(4); G_BAR;
  G_STAGE(G_SB(1, 0), cB0, voffB, 1); G_STAGE(G_SA(1, 0), cA0, voffA, 1); G_STAGE(G_SB(1, 1), cB1, voffB, 1);
  G_WAIT_V(6); G_BAR;
  for (int t = 0; t < nt - 2; t += 2) {
    G_LDB(B0, 0, 0); G_SCHED; G_LDA(At, 0, 0); G_STAGE(G_SA(1, 1), cA1, voffA, t + 1);
    G_WAIT_L(8); G_BAR; G_WAIT_L(0); G_MMA(0, 0, At, B0); G_BAR; G_SCHED;
    G_LDB(B1, 0, 1); G_STAGE(G_SB(0, 0), cB0, voffB, t + 2);
    G_BAR; G_WAIT_L(0); G_MMA(0, 1, At, B1); G_BAR;
    G_LDA(At, 0, 1); G_STAGE(G_SA(0, 0), cA0, voffA, t + 2);
    G_BAR; G_WAIT_L(0); G_MMA(1, 0, At, B0); G_BAR; G_SCHED;
    G_STAGE(G_SB(0, 1), cB1, voffB, t + 2);
    G_WAIT_V(6); G_BAR; G_MMA(1, 1, At, B1); G_BAR;
    G_LDB(B0, 1, 0); G_SCHED; G_LDA(At, 1, 0); G_STAGE(G_SA(0, 1), cA1, voffA, t + 2);
    G_WAIT_L(8); G_BAR; G_WAIT_L(0); G_MMA(0, 0, At, B0); G_BAR; G_SCHED;
    G_LDB(B1, 1, 1); G_STAGE(G_SB(1, 0), cB0, voffB, t + 3);
    G_BAR; G_WAIT_L(0); G_MMA(0, 1, At, B1); G_BAR;
    G_LDA(At, 1, 1); G_STAGE(G_SA(1, 0), cA0, voffA, t + 3);
    G_BAR; G_WAIT_L(0); G_MMA(1, 0, At, B0); G_BAR; G_SCHED;
    G_STAGE(G_SB(1, 1), cB1, voffB, t + 3);
    G_WAIT_V(6); G_BAR; G_MMA(1, 1, At, B1); G_BAR;
  }
  { G_LDB(B0, 0, 0); G_LDA(At, 0, 0); G_STAGE(G_SA(1, 1), cA1, voffA, nt - 1);
    G_BAR; G_WAIT_L(0); G_MMA(0, 0, At, B0); G_BAR;
    G_LDB(B1, 0, 1); G_BAR; G_WAIT_L(0); G_MMA(0, 1, At, B1); G_BAR;
    G_LDA(At, 0, 1); G_WAIT_V(4); G_BAR; G_WAIT_L(0); G_MMA(1, 0, At, B0); G_MMA(1, 1, At, B1); G_BAR; }
  { G_LDB(B0, 1, 0); G_LDA(At, 1, 0); G_WAIT_V(2); G_BAR; G_WAIT_L(0); G_MMA(0, 0, At, B0); G_BAR;
    G_LDB(B1, 1, 1); G_WAIT_V(0); G_BAR; G_WAIT_L(0); G_MMA(0, 1, At, B1); G_BAR;
    G_LDA(At, 1, 1); G_BAR; G_WAIT_L(0); G_MMA(1, 0, At, B0); G_MMA(1, 1, At, B1); G_BAR; }
  if (wr == 0) G_BAR;
  asm volatile("" ::: "memory");
  G_SCHED;
}

struct GStream { unsigned voff[2]; };
DI void stage_offsets(const int tid, const int ld, unsigned (&voff)[2]) {
#pragma unroll
  for (int i = 0; i < 2; ++i) { int R, C; stage_rc(tid * 16 + i * 8192, R, C); voff[i] = (unsigned)(R * ld + C) * 2u; }
}
#define GS_STAGE(bufoff, gptr, vo) do { _Pragma("unroll") for (int _i = 0; _i < 2; ++_i) \
    __builtin_amdgcn_global_load_lds((const unsigned*)((gptr) + (vo)[_i]), (LAS unsigned*)(lds + (bufoff) + ldsw + _i * 8192), 16, 0, 0); } while (0)
DI void gemm_begin(const int tid, const bf16_t* A, const bf16_t* Bm, const int ld, LAS char* lds) {
  const int wid = __builtin_amdgcn_readfirstlane(tid >> 6), wr = wid >> 2;
  unsigned vo[2]; stage_offsets(tid, ld, vo);
  const unsigned ldsw = (unsigned)wid * 1024u;
  const char* cA = (const char*)A; const char* cB = (const char*)Bm;
  const size_t hstep = (size_t)HALF * ld * 2, kstep = BK * 2;
  __syncthreads();
  GS_STAGE(G_SB(0, 0), cB, vo); GS_STAGE(G_SB(0, 1), cB + hstep, vo); GS_STAGE(G_SA(0, 0), cA, vo); GS_STAGE(G_SA(0, 1), cA + hstep, vo);
  if (wr == 1) G_BAR;
  G_WAIT_V(2); G_BAR;
  GS_STAGE(G_SB(1, 0), cB + kstep, vo); GS_STAGE(G_SA(1, 0), cA + kstep, vo); GS_STAGE(G_SB(1, 1), cB + hstep + kstep, vo);
  G_WAIT_V(6); G_BAR;
}
DI void gemm_end(const int tid) {
  const int wr = __builtin_amdgcn_readfirstlane(tid >> 6) >> 2;
  G_WAIT_V(0);
  if (wr == 0) G_BAR;
  G_BAR;
}
DI void gemm_unit(const int tid, const bf16_t* A, const bf16_t* Bm, const int ld, const int K,
                  const bf16_t* An, const bf16_t* Bn, const int ldn, LAS char* lds, f32x4 (&acc)[2][2][4][2]) {
  const int wid = __builtin_amdgcn_readfirstlane(tid >> 6), lane = tid & 63, wr = wid >> 2, wc = wid & 3, fr = lane & 15, fq = lane >> 4;
  unsigned voC[2], voN[2]; stage_offsets(tid, ld, voC); stage_offsets(tid, ldn, voN);
  const unsigned ldsw = (unsigned)wid * 1024u;
  const int aoff = lds_byte(wr * 64 + fr, fq * 8), boff = lds_byte(wc * 32 + fr, fq * 8);
  const char* cA = (const char*)A; const char* cB = (const char*)Bm;
  const char* nA = (const char*)An; const char* nB = (const char*)Bn;
  const size_t hstepC = (size_t)HALF * ld * 2, hstepN = (size_t)HALF * ldn * 2, kstep = BK * 2;
#pragma unroll
  for (int a = 0; a < 2; ++a)
#pragma unroll
    for (int b = 0; b < 2; ++b)
#pragma unroll
      for (int m = 0; m < 4; ++m)
#pragma unroll
        for (int n = 0; n < 2; ++n) acc[a][b][m][n] = (f32x4){0.f, 0.f, 0.f, 0.f};
  bf16x8 At[4][2], B0[2][2], B1[2][2];
  const int nt = K / BK;
  for (int t = 0; t < nt; t += 2) {
    const bool last = (t == nt - 2);
    const char* a1 = cA + (size_t)(t + 1) * kstep;
    const char* a2 = last ? nA : cA + (size_t)(t + 2) * kstep; const char* b2 = last ? nB : cB + (size_t)(t + 2) * kstep;
    const char* a3 = a2 + kstep; const char* b3 = b2 + kstep;
    const size_t hs2 = last ? hstepN : hstepC;
    unsigned vo2[2]; vo2[0] = last ? voN[0] : voC[0]; vo2[1] = last ? voN[1] : voC[1];
    G_LDB(B0, 0, 0); G_LDB(B1, 0, 1); G_SCHED; G_LDA(At, 0, 0); GS_STAGE(G_SA(1, 1), a1 + hstepC, voC);
    G_WAIT_V(8); G_WAIT_L(0); G_BAR; G_MMA(0, 0, At, B0); G_MMA(0, 1, At, B1); G_BAR; G_SCHED;
    G_LDA(At, 0, 1); GS_STAGE(G_SB(0, 0), b2, vo2); GS_STAGE(G_SB(0, 1), b2 + hs2, vo2); GS_STAGE(G_SA(0, 0), a2, vo2);
    G_WAIT_V(8); G_WAIT_L(0); G_BAR; G_MMA(1, 0, At, B0); G_MMA(1, 1, At, B1); G_BAR; G_SCHED;
    G_LDB(B0, 1, 0); G_LDB(B1, 1, 1); G_SCHED; G_LDA(At, 1, 0); GS_STAGE(G_SA(0, 1), a2 + hs2, vo2);
    G_WAIT_V(8); G_WAIT_L(0); G_BAR; G_MMA(0, 0, At, B0); G_MMA(0, 1, At, B1); G_BAR; G_SCHED;
    G_LDA(At, 1, 1); GS_STAGE(G_SB(1, 0), b3, vo2); GS_STAGE(G_SB(1, 1), b3 + hs2, vo2); GS_STAGE(G_SA(1, 0), a3, vo2);
    G_WAIT_V(8); G_WAIT_L(0); G_BAR; G_MMA(1, 0, At, B0); G_MMA(1, 1, At, B1); G_BAR; G_SCHED;
  }
  asm volatile("" ::: "memory");
  G_SCHED;
}

struct Geo { int wr, wc, fr, fq; };
DI Geo geo(const int tid) { const int wid = tid >> 6, lane = tid & 63; Geo g; g.wr = wid >> 2; g.wc = wid & 3; g.fr = lane & 15; g.fq = lane >> 4; return g; }
DI void st4(bf16_t* p, f32x4 v) { u32x2 o; o.x = pk2(v[0], v[1]); o.y = pk2(v[2], v[3]); *(u32x2*)p = o; }

enum { EP_PLAIN = 0, EP_SILU = 1, EP_ROPE = 2, EP_KFRAG = 4 };
DI u32x4 widen_pair(const u32x2 a, const u32x2 b) {
  const auto r0 = __builtin_amdgcn_permlane16_swap(a.x, b.x, false, false);
  const auto r1 = __builtin_amdgcn_permlane16_swap(a.y, b.y, false, false);
  u32x4 o; o.x = r0[0]; o.y = r1[0]; o.z = r0[1]; o.w = r1[1]; return o;
}
DI void unwiden_pair(const u32x4 w, u32x2& a, u32x2& b) {
  const auto r0 = __builtin_amdgcn_permlane16_swap(w.x, w.z, false, false);
  const auto r1 = __builtin_amdgcn_permlane16_swap(w.y, w.w, false, false);
  a.x = r0[0]; a.y = r1[0]; b.x = r0[1]; b.y = r1[1];
}
DI u32x4 widen32_pair(const u32x2 a, const u32x2 b) {
  const auto r0 = __builtin_amdgcn_permlane32_swap(a.x, b.x, false, false);
  const auto r1 = __builtin_amdgcn_permlane32_swap(a.y, b.y, false, false);
  u32x4 o; o.x = r0[0]; o.y = r1[0]; o.z = r0[1]; o.w = r1[1]; return o;
}
DI void unwiden32_pair(const u32x4 w, u32x2& a, u32x2& b) {
  const auto r0 = __builtin_amdgcn_permlane32_swap(w.x, w.z, false, false);
  const auto r1 = __builtin_amdgcn_permlane32_swap(w.y, w.w, false, false);
  a.x = r0[0]; a.y = r1[0]; b.x = r0[1]; b.y = r1[1];
}
DI u32x2 pk4(const f32x4 v) { u32x2 o; o.x = pk2(v[0], v[1]); o.y = pk2(v[2], v[3]); return o; }
DI void epi_rowmajor(const int tid, f32x4 (&acc)[2][2][4][2], bf16_t* dst, int ld, int tok0, int col0, int mode, const f32x2* rope) {
  const Geo g = geo(launder(tid));
  const int tokb = launder(tok0 + g.wc * 32 + g.fr);
  const int base = tokb * ld + col0 + g.wr * 64 + g.fq * 4;
#pragma unroll
  for (int ai = 0; ai < 2; ++ai)
#pragma unroll
    for (int bj = 0; bj < 2; ++bj)
#pragma unroll
      for (int n = 0; n < 2; ++n) {
        bf16_t* drow = dst + (base + (bj * 128 + n * 16) * ld + ai * 128);
        if ((mode & EP_ROPE) && g.wr == 0) {
          const int tok = tokb + bj * 128 + n * 16;
          const f32x2* cs = rope + (tok & (SEQ - 1)) * 16 + g.fq * 4;
          const f32x4 x1 = acc[ai][bj][0][n], x2 = acc[ai][bj][1][n];
#pragma unroll
          for (int j = 0; j < 4; ++j) { const f32x2 c = cs[j]; acc[ai][bj][0][n][j] = x1[j] * c.x - x2[j] * c.y; acc[ai][bj][1][n][j] = x2[j] * c.x + x1[j] * c.y; }
        }
        if (mode & EP_KFRAG) {
          const int tok = tokb + bj * 128 + n * 16, key = tok & (ld * 32 - 1);
          const int head = (col0 >> 7) + ai;
          bf16_t* kp = dst + ((size_t)((head * ld + (key >> 5)) * 8 + g.wr * 4) * 2 + (g.fq >> 1)) * 256 + (key & 31) * 8 + (g.fq & 1) * 512;
#pragma unroll
          for (int m = 0; m < 4; m += 2) *(u32x4*)(kp + m * 512) = widen_pair(pk4(acc[ai][bj][m][n]), pk4(acc[ai][bj][m + 1][n]));
        } else {
          bf16_t* drow2 = drow + ((g.fq & 1) ? 12 : 0);
#pragma unroll
          for (int m = 0; m < 4; m += 2) {
            f32x4 v = acc[ai][bj][m][n], u = acc[ai][bj][m + 1][n];
            if (mode & EP_SILU) {
              v[0] = silu_f(v[0]); v[1] = silu_f(v[1]); v[2] = silu_f(v[2]); v[3] = silu_f(v[3]);
              u[0] = silu_f(u[0]); u[1] = silu_f(u[1]); u[2] = silu_f(u[2]); u[3] = silu_f(u[3]);
            }
            *(u32x4*)(drow2 + m * 16) = widen_pair(pk4(v), pk4(u));
          }
        }
        __builtin_amdgcn_sched_barrier(0);
      }
}
DI void epi_vfrag(const int tid, f32x4 (&acc)[2][2][4][2], bf16_t* dstF, int ntile, int s0, int head0) {
  const Geo g = geo(launder(tid));
  const int lanepart = launder(((g.fq & 1) * 32 + g.fr) * 8);
#pragma unroll
  for (int ai = 0; ai < 2; ++ai)
#pragma unroll
    for (int bj = 0; bj < 2; ++bj)
#pragma unroll
      for (int m = 0; m < 4; m += 2)
#pragma unroll
        for (int n = 0; n < 2; ++n) {
          const int ms = m + (g.fq >> 1);
          const int kt = (s0 >> 5) + ai * 4 + g.wr * 2 + (ms >> 1);
          const size_t idx = ((size_t)(((head0 + bj) * ntile + kt) * 4 + g.wc) * 2 + (ms & 1)) * 512 + n * 128 + lanepart;
          *(u32x4*)(dstF + idx) = widen32_pair(pk4(acc[ai][bj][m][n]), pk4(acc[ai][bj][m + 1][n]));
        }
}
DI void epi_transposed(const int tid, f32x4 (&acc)[2][2][4][2], bf16_t* dstT, int slen, int s0, int feat0) {
  const Geo g = geo(launder(tid));
  const int featb = launder(feat0 + g.wc * 32 + g.fr);
  const int base = featb * slen + s0 + g.wr * 64 + (g.fq & 1) * 8 + (g.fq >> 1) * 16;
#pragma unroll
  for (int ai = 0; ai < 2; ++ai)
#pragma unroll
    for (int bj = 0; bj < 2; ++bj)
#pragma unroll
      for (int m = 0; m < 4; m += 2)
#pragma unroll
        for (int n = 0; n < 2; ++n)
          *(u32x4*)(dstT + (base + (bj * 128 + n * 16) * slen + ai * 128 + m * 16)) = widen32_pair(pk4(acc[ai][bj][m][n]), pk4(acc[ai][bj][m + 1][n]));
}
DI void epi_gate(const int tid, f32x4 (&acc)[2][2][4][2], const bf16_t* T, bf16_t* Y, int tok0, int col0, bool first) {
  const Geo g = geo(launder(tid));
  const int tokb = launder(tok0 + g.wc * 32 + g.fr);
  const int base = tokb * DM + col0 + g.wr * 64 + g.fq * 4 + ((g.fq & 1) ? 12 : 0);
#pragma unroll
  for (int ai = 0; ai < 2; ++ai)
#pragma unroll
    for (int bj = 0; bj < 2; ++bj)
#pragma unroll
      for (int n = 0; n < 2; ++n)
#pragma unroll
        for (int m = 0; m < 4; m += 2) {
          const int off = base + (bj * 128 + n * 16) * DM + ai * 128 + m * 16;
          u32x2 ta, tb; unwiden_pair(*(const u32x4*)(T + off), ta, tb);
          const f32x4 a = acc[ai][bj][m][n], b = acc[ai][bj][m + 1][n];
          f32x4 ya, yb;
          ya[0] = sigmoid_f(a[0]) * bf_lo(ta.x); ya[1] = sigmoid_f(a[1]) * bf_hi(ta.x); ya[2] = sigmoid_f(a[2]) * bf_lo(ta.y); ya[3] = sigmoid_f(a[3]) * bf_hi(ta.y);
          yb[0] = sigmoid_f(b[0]) * bf_lo(tb.x); yb[1] = sigmoid_f(b[1]) * bf_hi(tb.x); yb[2] = sigmoid_f(b[2]) * bf_lo(tb.y); yb[3] = sigmoid_f(b[3]) * bf_hi(tb.y);
          if (!first) {
            u32x2 oa, ob; unwiden_pair(*(const u32x4*)(Y + off), oa, ob);
            ya[0] += bf_lo(oa.x); ya[1] += bf_hi(oa.x); ya[2] += bf_lo(oa.y); ya[3] += bf_hi(oa.y);
            yb[0] += bf_lo(ob.x); yb[1] += bf_hi(ob.x); yb[2] += bf_lo(ob.y); yb[3] += bf_hi(ob.y);
          }
          *(u32x4*)(Y + off) = widen_pair(pk4(ya), pk4(yb));
        }
}
DI void epi_out(const int tid, f32x4 (&acc)[2][2][4][2], const float* x, float* out, float* rowss, int tok0, int col0) {
  const Geo g = geo(launder(tid));
  const int tokb = launder(tok0 + g.wc * 32 + g.fr);
  const int base = tokb * DM + col0 + g.wr * 64 + g.fq * 4;
#pragma unroll
  for (int bj = 0; bj < 2; ++bj)
#pragma unroll
    for (int n = 0; n < 2; ++n) {
      float ss = 0.f;
#pragma unroll
      for (int ai = 0; ai < 2; ++ai)
#pragma unroll
        for (int m = 0; m < 4; ++m) {
          const int off = base + (bj * 128 + n * 16) * DM + ai * 128 + m * 16;
          const f32x4 xv = *(const f32x4*)(x + off);
          const f32x4 z = xv + acc[ai][bj][m][n];
          *(f32x4*)(out + off) = z;
          ss += z[0] * z[0] + z[1] * z[1] + z[2] * z[2] + z[3] * z[3];
        }
      ss += __shfl_xor(ss, 16); ss += __shfl_xor(ss, 32);
      if (g.fq == 0) atomicAdd(rowss + (tokb + bj * 128 + n * 16), ss);
    }
}

DI void epi_out_norm(const int tid, f32x4 (&acc)[2][2][4][2], const float* x, float* out, float* rowss, unsigned* cnt, const float* gfin,
                     int tok0, int col0, LAS unsigned* lcnt) {
  const Geo g = geo(launder(tid));
  const int lane = tid & 63;
  const int tokb = launder(tok0 + g.wc * 32 + g.fr);
  const int base = tokb * DM + col0 + g.wr * 64 + g.fq * 4;
#pragma unroll
  for (int bj = 0; bj < 2; ++bj)
#pragma unroll
    for (int n = 0; n < 2; ++n) {
      float ss = 0.f;
#pragma unroll
      for (int ai = 0; ai < 2; ++ai)
#pragma unroll
        for (int m = 0; m < 4; ++m) {
          const int off = base + (bj * 128 + n * 16) * DM + ai * 128 + m * 16;
          const f32x4 xv = *(const f32x4*)(x + off);
          const f32x4 z = xv + acc[ai][bj][m][n];
          acc[ai][bj][m][n] = z;
          ss += z[0] * z[0] + z[1] * z[1] + z[2] * z[2] + z[3] * z[3];
        }
      ss += __shfl_xor(ss, 16); ss += __shfl_xor(ss, 32);
      if (g.fq == 0) __hip_atomic_fetch_add(rowss + (tokb + bj * 128 + n * 16), ss, __ATOMIC_RELAXED, __HIP_MEMORY_SCOPE_AGENT);
    }
  asm volatile("s_waitcnt vmcnt(0)" ::: "memory");
  if (lane == 0) {
    const unsigned old = __hip_atomic_fetch_add((unsigned*)lcnt, 1u, __ATOMIC_RELAXED, __HIP_MEMORY_SCOPE_WORKGROUP);
    if (old == 7u) {
      __hip_atomic_store((unsigned*)lcnt, 0u, __ATOMIC_RELAXED, __HIP_MEMORY_SCOPE_WORKGROUP);
      __builtin_amdgcn_fence(__ATOMIC_RELEASE, "agent");
      __hip_atomic_fetch_add(cnt, 1u, __ATOMIC_RELAXED, __HIP_MEMORY_SCOPE_AGENT);
    }
  }
  while (__hip_atomic_load(cnt, __ATOMIC_RELAXED, __HIP_MEMORY_SCOPE_AGENT) < 4u) __builtin_amdgcn_s_sleep(1);
  __builtin_amdgcn_fence(__ATOMIC_ACQUIRE, "agent");
  f32x4 gfv[2][4];
#pragma unroll
  for (int ai = 0; ai < 2; ++ai)
#pragma unroll
    for (int m = 0; m < 4; ++m) gfv[ai][m] = *(const f32x4*)(gfin + col0 + g.wr * 64 + g.fq * 4 + ai * 128 + m * 16);
#pragma unroll
  for (int bj = 0; bj < 2; ++bj)
#pragma unroll
    for (int n = 0; n < 2; ++n) {
      const float tot = __hip_atomic_load(rowss + (tokb + bj * 128 + n * 16), __ATOMIC_RELAXED, __HIP_MEMORY_SCOPE_AGENT);
      const float rs = rsqrtf(tot * (1.f / DM) + 1e-6f);
#pragma unroll
      for (int ai = 0; ai < 2; ++ai)
#pragma unroll
        for (int m = 0; m < 4; ++m) {
          const int off = base + (bj * 128 + n * 16) * DM + ai * 128 + m * 16;
          const f32x4 gg = gfv[ai][m];
          const f32x4 z = acc[ai][bj][m][n];
          f32x4 o; o[0] = z[0] * rs * gg[0]; o[1] = z[1] * rs * gg[1]; o[2] = z[2] * rs * gg[2]; o[3] = z[3] * rs * gg[3];
          *(f32x4*)(out + off) = o;
        }
    }
}

DI void p0_transpose_item(const float* W, int K, int N, bf16_t* WT, LAS float* scr, int item, int lane) {
  const int nblk = N / 32, kb = item / nblk, nb = item % nblk, k0 = 64 * kb, n0 = 32 * nb;
#pragma unroll 8
  for (int i = 0; i < 32; ++i) { const int kk = 2 * i + (lane >> 5); scr[kk * 33 + (lane & 31)] = W[(size_t)(k0 + kk) * N + n0 + (lane & 31)]; }
  lds_wait();
  const int c = lane & 7;
#pragma unroll
  for (int j = 0; j < 4; ++j) {
    const int n = (lane >> 3) + 8 * j; const LAS float* s = scr + (8 * c) * 33 + n;
    u32x4 o; o.x = pk2(s[0 * 33], s[1 * 33]); o.y = pk2(s[2 * 33], s[3 * 33]); o.z = pk2(s[4 * 33], s[5 * 33]); o.w = pk2(s[6 * 33], s[7 * 33]);
    *(u32x4*)(WT + (size_t)(n0 + n) * K + k0 + 8 * c) = o;
  }
  lds_wait();
}
DI void rms_row_bf16(const float* xr, const float* gw, bf16_t* orow, int lane) {
  f32x4 v[4]; float s = 0.f;
#pragma unroll
  for (int j = 0; j < 4; ++j) { v[j] = ((const f32x4*)xr)[lane + 64 * j]; s += v[j][0] * v[j][0] + v[j][1] * v[j][1] + v[j][2] * v[j][2] + v[j][3] * v[j][3]; }
  s = wave_sum(s);
  const float rs = rsqrtf(s * (1.f / DM) + 1e-6f);
#pragma unroll
  for (int j = 0; j < 4; ++j) {
    const f32x4 gg = ((const f32x4*)gw)[lane + 64 * j];
    u32x2 o; o.x = pk2(v[j][0] * rs * gg[0], v[j][1] * rs * gg[1]); o.y = pk2(v[j][2] * rs * gg[2], v[j][3] * rs * gg[3]);
    *(u32x2*)(orow + 4 * (lane + 64 * j)) = o;
  }
}
DI void phase0(const Params& p, LAS char* lds, const int wv) {
  const int tid = make_tid(wv), wave = tid >> 6, lane = tid & 63, G = gridDim.x;
  const int gw = blockIdx.x * 8 + wave, NGW = G * 8;
  const size_t gt = (size_t)blockIdx.x * NTHREADS + tid, NGT = (size_t)G * NTHREADS;
  char* ws = p.ws;
  if (gt < 144) ((unsigned*)(ws + OFF_BAR))[gt] = 0u;
  if (gt < 24 * 32) ((unsigned*)(ws + OFF_GCNT))[gt] = 0u;
  if (gt < 128) ((unsigned*)(ws + OFF_C5))[gt] = 0u;
  for (size_t i = gt; i < MTOK; i += NGT) ((float*)(ws + OFF_ROWSS))[i] = 0.f;
  for (size_t i = gt; i < (size_t)SEQ * 16; i += NGT) {
    const int pos = (int)(i >> 4), f = (int)(i & 15);
    const float inv = powf(500000.0f, -(float)f * (1.f / 16.f));
    const float ang = (float)pos * inv;
    f32x2 cs; cs.x = cosf(ang); cs.y = sinf(ang);
    ((f32x2*)(ws + OFF_ROPE))[i] = cs;
  }
  f32x4 gx[4];
#pragma unroll
  for (int j = 0; j < 2; ++j) { gx[2 * j] = ((const f32x4*)p.norm_g)[2 * (lane + 64 * j)]; gx[2 * j + 1] = ((const f32x4*)p.norm_g)[2 * (lane + 64 * j) + 1]; }
  for (int r0 = gw; r0 < MTOK + NB * 256; r0 += 4 * NGW) {
    f32x4 v[4][4]; float ss[4]; bf16_t* osel[4]; bool ok[4], ismem[4];
#pragma unroll
    for (int k = 0; k < 4; ++k) {
      const int r = r0 + k * NGW;
      ok[k] = r < MTOK + NB * 256;
      const int rc = ok[k] ? r : r0;
      const float* xr;
      ismem[k] = rc >= MTOK;
      if (!ismem[k]) { xr = p.x + (size_t)rc * DM; osel[k] = (bf16_t*)(ws + OFF_HB) + (size_t)rc * DM; }
      else { const int m = rc - MTOK; xr = p.mem + (size_t)m * DM; osel[k] = (bf16_t*)(ws + OFF_MEMN) + (size_t)m * DM; }
#pragma unroll
      for (int j = 0; j < 2; ++j) { v[k][2 * j] = ((const f32x4*)xr)[2 * (lane + 64 * j)]; v[k][2 * j + 1] = ((const f32x4*)xr)[2 * (lane + 64 * j) + 1]; }
    }
#pragma unroll
    for (int k = 0; k < 4; ++k) {
      float s_ = 0.f;
#pragma unroll
      for (int j = 0; j < 4; ++j) s_ += v[k][j][0] * v[k][j][0] + v[k][j][1] * v[k][j][1] + v[k][j][2] * v[k][j][2] + v[k][j][3] * v[k][j][3];
      ss[k] = s_;
    }
#pragma unroll
    for (int o = 1; o < 64; o <<= 1) {
#pragma unroll
      for (int k = 0; k < 4; ++k) ss[k] += __shfl_xor(ss[k], o);
    }
#pragma unroll
    for (int k = 0; k < 4; ++k) {
      if (ok[k]) {
        const float rs = rsqrtf(ss[k] * (1.f / DM) + 1e-6f);
#pragma unroll
        for (int j = 0; j < 2; ++j) {
          f32x4 g0 = gx[2 * j], g1 = gx[2 * j + 1];
          if (ismem[k]) { g0 = ((const f32x4*)p.mem_norm_g)[2 * (lane + 64 * j)]; g1 = ((const f32x4*)p.mem_norm_g)[2 * (lane + 64 * j) + 1]; }
          const f32x4 a = v[k][2 * j], c = v[k][2 * j + 1];
          u32x4 o; o.x = pk2(a[0] * rs * g0[0], a[1] * rs * g0[1]); o.y = pk2(a[2] * rs * g0[2], a[3] * rs * g0[3]);
          o.z = pk2(c[0] * rs * g1[0], c[1] * rs * g1[1]); o.w = pk2(c[2] * rs * g1[2], c[3] * rs * g1[3]);
          *(u32x4*)(osel[k] + 8 * (lane + 64 * j)) = o;
        }
      }
    }
  }
  LAS float* scr = (LAS float*)(lds + wave * 8448);
  constexpr int I_IN = 16 * (INW / 32), I_MKV = 16 * 32, I_A = 12 * 32, I_C = 8 * 32, I_O = 16 * 32;
  constexpr int NITEMS = I_IN + I_MKV + 2 * I_A + I_C + I_O;
  for (int it = gw; it < NITEMS; it += NGW) {
    int r = it;
    if (r < I_IN) { p0_transpose_item(p.w_in, 1024, INW, (bf16_t*)(ws + OFF_WIN), scr, r, lane); continue; } r -= I_IN;
    if (r < I_MKV) { p0_transpose_item(p.w_mkv, 1024, 1024, (bf16_t*)(ws + OFF_WMKV), scr, r, lane); continue; } r -= I_MKV;
    if (r < I_A) { p0_transpose_item(p.w_a, 768, 1024, (bf16_t*)(ws + OFF_WA), scr, r, lane); continue; } r -= I_A;
    if (r < I_A) { p0_transpose_item(p.w_b, 768, 1024, (bf16_t*)(ws + OFF_WB), scr, r, lane); continue; } r -= I_A;
    if (r < I_C) { p0_transpose_item(p.w_c, 512, 1024, (bf16_t*)(ws + OFF_WC), scr, r, lane); continue; } r -= I_C;
    p0_transpose_item(p.w_out, 1024, 1024, (bf16_t*)(ws + OFF_WO), scr, r, lane);
  }
}

struct P1Ops { const bf16_t *A, *B; int tt, ct; bool memkv, tr; };
DI P1Ops p1_ops(char* ws, int L, bool swz, int xcd) {
  P1Ops o;
  if (swz) {
    if (L < 400) { const int grp = L / 200, r = L % 200; o.tt = xcd * 16 + grp * 8 + (r & 7); o.ct = r >> 3; o.memkv = false; }
    else { o.memkv = true; const int t = xcd * 2 + (L - 400); o.tt = t >> 2; o.ct = t & 3; }
  } else {
    if (L < 3200) { o.tt = L / 25; o.ct = L % 25; o.memkv = false; } else { o.memkv = true; o.tt = (L - 3200) >> 2; o.ct = (L - 3200) & 3; }
  }
  const bf16_t *Wt, *Xt;
  if (!o.memkv) {
    Wt = (const bf16_t*)(ws + OFF_WIN) + (size_t)o.ct * 256 * DM; Xt = (const bf16_t*)(ws + OFF_HB) + (size_t)o.tt * 256 * DM;
    o.tr = (o.ct >= 6 && o.ct < 9) || (o.ct >= 15 && o.ct < 18);
  } else {
    Wt = (const bf16_t*)(ws + OFF_WMKV) + (size_t)o.ct * 256 * DM; Xt = (const bf16_t*)(ws + OFF_MEMN) + (size_t)o.tt * 256 * DM;
    o.tr = o.ct >= 2;
  }
  o.A = o.tr ? Xt : Wt; o.B = o.tr ? Wt : Xt;
  return o;
}
DI void phase1(const Params& p, LAS char* lds, const int wv) {
  char* ws = p.ws;
  const int tid = make_tid(wv);
  const int G = gridDim.x, b = blockIdx.x;
  const f32x2* rope = (const f32x2*)(ws + OFF_ROPE);
  const bool swz = (G % 8) == 0;
  const int per = swz ? G / 8 : G, xcd = swz ? (b & 7) : 0, slot = swz ? (b >> 3) : b;
  const int LMAX = swz ? 402 : 3216;
  if (slot >= LMAX) return;
  { const P1Ops o = p1_ops(ws, slot, swz, xcd); gemm_begin(tid, o.A, o.B, DM, lds); }
  for (int L = slot; L < LMAX; L += per) {
    const P1Ops o = p1_ops(ws, L, swz, xcd);
    const P1Ops nx = p1_ops(ws, (L + per < LMAX) ? L + per : L, swz, xcd);
    const int tt = o.tt, ct = o.ct; const bool tr = o.tr;
    bf16_t* dst; int dld, dcol, mode, slen, s0, tok0;
    if (!o.memkv) {
      tok0 = tt * 256; slen = SEQ; s0 = (tt & 31) * 256;
      const int bb = tt >> 5;
      if (ct < 3) { dst = (bf16_t*)(ws + OFF_Q); dld = AW; dcol = ct * 256; mode = EP_ROPE; }
      else if (ct < 6) { dst = (bf16_t*)(ws + OFF_K) + (size_t)bb * 6 * 256 * 4096; dld = 256; dcol = (ct - 3) * 256; mode = EP_ROPE | EP_KFRAG; }
      else if (ct < 9) { dst = (bf16_t*)(ws + OFF_VT) + (size_t)bb * 6 * 256 * 4096; dld = 1; dcol = (ct - 6) * 2; mode = EP_PLAIN; }
      else if (ct < 12) { dst = (bf16_t*)(ws + OFF_GA); dld = AW; dcol = (ct - 9) * 256; mode = EP_SILU; }
      else if (ct < 15) { dst = (bf16_t*)(ws + OFF_UB); dld = AW; dcol = (ct - 12) * 256; mode = EP_PLAIN; }
      else if (ct < 18) { dst = (bf16_t*)(ws + OFF_VBT) + (size_t)bb * AW * SEQ; dld = 0; dcol = (ct - 15) * 256; mode = EP_PLAIN; }
      else if (ct < 21) { dst = (bf16_t*)(ws + OFF_GB); dld = AW; dcol = (ct - 18) * 256; mode = EP_SILU; }
      else if (ct < 23) { dst = (bf16_t*)(ws + OFF_QC); dld = CW; dcol = (ct - 21) * 256; mode = EP_PLAIN; }
      else { dst = (bf16_t*)(ws + OFF_GC); dld = CW; dcol = (ct - 23) * 256; mode = EP_SILU; }
    } else {
      tok0 = tt * 256; slen = 256; s0 = 0; mode = EP_PLAIN;
      if (!tr) { dst = (bf16_t*)(ws + OFF_MEMK) + (size_t)tt * 4 * 8 * 4096; dld = 8; dcol = ct * 256; mode = EP_KFRAG; }
      else { dst = (bf16_t*)(ws + OFF_MEMVT) + (size_t)tt * 4 * 8 * 4096; dld = 1; dcol = (ct - 2) * 2; }
    }
    f32x4 acc[2][2][4][2];
    gemm_unit(tid, o.A, o.B, DM, DM, nx.A, nx.B, DM, lds, acc);
    if (!tr) epi_rowmajor(tid, acc, dst, dld, tok0, dcol, mode, rope);
    else if (dld == 1) epi_vfrag(tid, acc, dst, slen >> 5, s0, dcol);
    else epi_transposed(tid, acc, dst, slen, s0, dcol);
  }
  gemm_end(tid);
}

DI void kstat_item(const int tid, const bf16_t* blk, bf16_t* kmh, const int blkidx, float* max2_out, LAS char* lds) {
  const int ks = tid >> 6, lane = tid & 63;
  LAS float* n2p = (LAS float*)lds;
  LAS float* redm = n2p + 4096;
  __syncthreads();
  float cs[8];
#pragma unroll
  for (int e = 0; e < 8; ++e) cs[e] = 0.f;
#pragma unroll
  for (int kt = 0; kt < 8; ++kt) {
    const u32x4 v = *(const u32x4*)(blk + (size_t)((kt * 8 + ks) * 64 + lane) * 8);
    const float f[8] = {bf_lo(v.x), bf_hi(v.x), bf_lo(v.y), bf_hi(v.y), bf_lo(v.z), bf_hi(v.z), bf_lo(v.w), bf_hi(v.w)};
    float n2 = 0.f;
#pragma unroll
    for (int e = 0; e < 8; ++e) { cs[e] += f[e]; n2 += f[e] * f[e]; }
    n2p[(ks * 2 + (lane >> 5)) * 256 + kt * 32 + (lane & 31)] = n2;
  }
#pragma unroll
  for (int e = 0; e < 8; ++e) {
    float c = cs[e];
    c += __shfl_xor(c, 1); c += __shfl_xor(c, 2); c += __shfl_xor(c, 4); c += __shfl_xor(c, 8); c += __shfl_xor(c, 16);
    cs[e] = c * (1.f / 256.f);
  }
  if (kmh && (lane & 31) == 0) {
    u32x4 hi, lo;
    hi.x = pk2(cs[0], cs[1]); hi.y = pk2(cs[2], cs[3]); hi.z = pk2(cs[4], cs[5]); hi.w = pk2(cs[6], cs[7]);
    lo.x = pk2(cs[0] - bf_lo(hi.x), cs[1] - bf_hi(hi.x)); lo.y = pk2(cs[2] - bf_lo(hi.y), cs[3] - bf_hi(hi.y));
    lo.z = pk2(cs[4] - bf_lo(hi.z), cs[5] - bf_hi(hi.z)); lo.w = pk2(cs[6] - bf_lo(hi.w), cs[7] - bf_hi(hi.w));
    bf16_t* d = kmh + ((size_t)(ks * 64 + (lane >> 5) * 32 + blkidx)) * 8;
    *(u32x4*)d = hi; *(u32x4*)(d + 98304) = lo;
  }
  __syncthreads();
  if (tid < 256) {
    float n = 0.f;
#pragma unroll
    for (int k = 0; k < 16; ++k) n += n2p[k * 256 + tid];
    n = wave_max(n);
    if ((tid & 63) == 0) redm[tid >> 6] = n;
  }
  __syncthreads();
  if (tid == 0) *max2_out = fmaxf(fmaxf(redm[0], redm[1]), fmaxf(redm[2], redm[3]));
  __syncthreads();
}

DI u32x4 pack_w(const f32x4 wa, const f32x4 wb) { u32x4 o; o.x = pk2(wa[0], wa[1]); o.y = pk2(wa[2], wa[3]); o.z = pk2(wb[0], wb[1]); o.w = pk2(wb[2], wb[3]); return o; }
DI u32x4 pack_w_masked(const f32x4 wa, const f32x4 wb, const int sa, const int t) {
  u32x4 o; const int sb = sa + 8;
  o.x = pk2(sa + 0 <= t ? wa[0] : 0.f, sa + 1 <= t ? wa[1] : 0.f); o.y = pk2(sa + 2 <= t ? wa[2] : 0.f, sa + 3 <= t ? wa[3] : 0.f);
  o.z = pk2(sb + 0 <= t ? wb[0] : 0.f, sb + 1 <= t ? wb[1] : 0.f); o.w = pk2(sb + 2 <= t ? wb[2] : 0.f, sb + 3 <= t ? wb[3] : 0.f);
  return o;
}
DI void gmlp_item(const int tid, const Params& p, LAS char* lds, int item) {
  char* ws = p.ws;
  const int w = tid >> 6, lane = tid & 63, r = lane & 31, hh = lane >> 5;
  const int b = item >> 6, ch = item & 63, s0 = ch * 128, tok0 = b * SEQ + s0;
  const bf16_t* VBT = (const bf16_t*)(ws + OFF_VBT) + (size_t)b * AW * SEQ + s0;
  LAS float* red = (LAS float*)lds;
  LAS float* red2 = red + 4096;
  LAS float* ra = red + 8192;
  LAS float* rb = ra + 128;
  __syncthreads();
  {
    const int oct = tid & 15, cpart = tid >> 4;
    float sum[8], sq[8];
#pragma unroll
    for (int e = 0; e < 8; ++e) { sum[e] = 0.f; sq[e] = 0.f; }
#pragma unroll 8
    for (int i = 0; i < 24; ++i) {
      const u32x4 v = *(const u32x4*)(VBT + (size_t)(cpart + 32 * i) * SEQ + oct * 8);
      const float f[8] = {bf_lo(v.x), bf_hi(v.x), bf_lo(v.y), bf_hi(v.y), bf_lo(v.z), bf_hi(v.z), bf_lo(v.w), bf_hi(v.w)};
#pragma unroll
      for (int e = 0; e < 8; ++e) { sum[e] += f[e]; sq[e] += f[e] * f[e]; }
    }
#pragma unroll
    for (int e = 0; e < 8; ++e) { red[cpart * 128 + oct * 8 + e] = sum[e]; red2[cpart * 128 + oct * 8 + e] = sq[e]; }
    __syncthreads();
    if (tid < 128) {
      float su = 0.f, s2 = 0.f;
#pragma unroll 8
      for (int k = 0; k < 32; ++k) { su += red[k * 128 + tid]; s2 += red2[k * 128 + tid]; }
      const float mu = su * (1.f / AW); const float var = fmaxf(s2 * (1.f / AW) - mu * mu, 0.f);
      const float rr = rsqrtf(var + 1e-6f);
      ra[tid] = rr; rb[tid] = mu * rr;
    }
    __syncthreads();
  }
  const int ct = w & 3, tp = w >> 2;
  const bf16_t* UB = (const bf16_t*)(ws + OFF_UB);
  bf16_t* OB = (bf16_t*)((char*)p.out + DO_OB);
  const bf16_t* GB = (const bf16_t*)(ws + OFF_GB);
#pragma unroll 1
  for (int g = 0; g < 6; ++g) {
    f32x16 acc0, acc1;
#pragma unroll
    for (int i = 0; i < 16; ++i) { acc0[i] = 0.f; acc1[i] = 0.f; }
    const int c = g * 128 + ct * 32 + r;
    const float lgc = p.ln_g[c];
    const int t0 = (2 * tp) * 32 + r, t1 = t0 + 32;
    const float* w0 = p.w_sp + ((size_t)g * 128 + t0) * 128;
    const float* w1 = w0 + 32 * 128;
#pragma unroll
    for (int ks = 0; ks < 8; ++ks) {
      if (ks <= 4 * tp + 3) {
        const u32x4 raw = *(const u32x4*)(VBT + (size_t)c * SEQ + 16 * ks + 8 * hh);
        const f32x4 r0 = *(const LAS f32x4*)(ra + 16 * ks + 8 * hh), r1 = *(const LAS f32x4*)(ra + 16 * ks + 8 * hh + 4);
        const f32x4 m0 = *(const LAS f32x4*)(rb + 16 * ks + 8 * hh), m1 = *(const LAS f32x4*)(rb + 16 * ks + 8 * hh + 4);
        u32x4 a;
        a.x = pk2((bf_lo(raw.x) * r0[0] - m0[0]) * lgc, (bf_hi(raw.x) * r0[1] - m0[1]) * lgc);
        a.y = pk2((bf_lo(raw.y) * r0[2] - m0[2]) * lgc, (bf_hi(raw.y) * r0[3] - m0[3]) * lgc);
        a.z = pk2((bf_lo(raw.z) * r1[0] - m1[0]) * lgc, (bf_hi(raw.z) * r1[1] - m1[1]) * lgc);
        a.w = pk2((bf_lo(raw.w) * r1[2] - m1[2]) * lgc, (bf_hi(raw.w) * r1[3] - m1[3]) * lgc);
        const bf16x8 af = __builtin_bit_cast(bf16x8, a);
        const int sa = 16 * ks + 4 * hh;
        {
          const f32x4 wa = *(const f32x4*)(w1 + sa), wb = *(const f32x4*)(w1 + sa + 8);
          const u32x4 bb = (ks >= 4 * tp + 2) ? pack_w_masked(wa, wb, sa, t1) : pack_w(wa, wb);
          acc1 = mfma32(af, __builtin_bit_cast(bf16x8, bb), acc1);
        }
        if (ks <= 4 * tp + 1) {
          const f32x4 wa = *(const f32x4*)(w0 + sa), wb = *(const f32x4*)(w0 + sa + 8);
          const u32x4 bb = (ks >= 4 * tp) ? pack_w_masked(wa, wb, sa, t0) : pack_w(wa, wb);
          acc0 = mfma32(af, __builtin_bit_cast(bf16x8, bb), acc0);
        }
      }
    }
#pragma unroll
    for (int T = 0; T < 2; ++T) {
      const int t = T ? t1 : t0;
      const float bias = p.b_sp[g * 128 + t];
      const size_t rowoff = (size_t)(tok0 + t) * AW + g * 128 + ct * 32 + 8 * hh;
#pragma unroll
      for (int i4 = 0; i4 < 4; i4 += 2) {
        const size_t off = rowoff + 8 * i4;
        u32x2 ua, ub2, ga, gb2;
        unwiden32_pair(*(const u32x4*)(UB + off), ua, ub2);
        unwiden32_pair(*(const u32x4*)(GB + off), ga, gb2);
        f32x4 oa, ob;
#pragma unroll
        for (int e = 0; e < 4; ++e) {
          const float a0 = T ? acc1[4 * i4 + e] : acc0[4 * i4 + e], a1 = T ? acc1[4 * i4 + 4 + e] : acc0[4 * i4 + 4 + e];
          const unsigned uw0 = (e < 2) ? ua.x : ua.y, gw0 = (e < 2) ? ga.x : ga.y, uw1 = (e < 2) ? ub2.x : ub2.y, gw1 = (e < 2) ? gb2.x : gb2.y;
          const float u0 = (e & 1) ? bf_hi(uw0) : bf_lo(uw0), g0 = (e & 1) ? bf_hi(gw0) : bf_lo(gw0);
          const float u1 = (e & 1) ? bf_hi(uw1) : bf_lo(uw1), g1 = (e & 1) ? bf_hi(gw1) : bf_lo(gw1);
          oa[e] = u0 * (a0 + bias) * g0; ob[e] = u1 * (a1 + bias) * g1;
        }
        *(u32x4*)(OB + off) = widen32_pair(pk4(oa), pk4(ob));
      }
    }
  }
}

DI void phase2(const Params& p, LAS char* lds, const int wv) {
  char* ws = p.ws;
  const int tid = make_tid(wv);
  for (int it = blockIdx.x; it < 256 + 768 + 16; it += gridDim.x) {
    if (it < 256) { for (int rg = 0; rg < REP2G; ++rg) gmlp_item(tid, p, lds, it); }
    else if (it < 1024) {
      const int k = it - 256, blk = k & 31, bh = k >> 5, h = bh % 6, b = bh / 6;
      kstat_item(tid, (const bf16_t*)(ws + OFF_K) + ((size_t)bh * 256 + blk * 8) * 4096,
                 (bf16_t*)(ws + OFF_KMEAN) + (size_t)bh * 4096, blk, (float*)(ws + OFF_KMAX2) + k, lds);
    } else {
      const int k = it - 1024, hd = k & 3, b = k >> 2;
      kstat_item(tid, (const bf16_t*)(ws + OFF_MEMK) + (size_t)k * 8 * 4096, nullptr, 0, (float*)(ws + OFF_MKMAX2) + k, lds);
    }
  }
}

constexpr float ATT_SC = 0.08838834764831845f * 1.4426950408889634f;
DI bf16x8 ldfrag(const bf16_t* p) { return *(const bf16x8*)p; }
DI bf16x8 ldfrag(const LAS bf16_t* p) { return *(const LAS bf16x8*)p; }
template <class KP>
DI void attn_unit(const bf16x8 (&qf)[8], KP Kt, KP Vt, int nkt, float cs, int qpos, int hh, f32x16 (&o)[4], float& lsum) {
  bf16x8 kf[8], vf[8];
#pragma unroll
  for (int f = 0; f < 8; ++f) kf[f] = ldfrag(Kt + f * 512);
#pragma unroll
  for (int f = 0; f < 8; ++f) vf[f] = ldfrag(Vt + f * 512);
#pragma unroll 1
  for (int kt = 0; kt < nkt; ++kt) {
    f32x16 s;
#pragma unroll
    for (int i = 0; i < 16; ++i) s[i] = 0.f;
#pragma unroll
    for (int ks = 0; ks < 8; ++ks) s = mfma32(kf[ks], qf[ks], s);
    const int ktn = (kt + 1 < nkt) ? kt + 1 : kt;
#pragma unroll
    for (int f = 0; f < 8; ++f) kf[f] = ldfrag(Kt + ktn * 4096 + f * 512);
#pragma unroll
    for (int i = 0; i < 16; ++i) {
      const int key = kt * 32 + crow(i, hh);
      float pv = __builtin_amdgcn_exp2f(s[i] * ATT_SC - cs);
      pv = key > qpos ? 0.f : pv;
      lsum += pv; s[i] = pv;
    }
    u32x4 a, b;
    a.x = pk2(s[0], s[1]); a.y = pk2(s[2], s[3]); a.z = pk2(s[4], s[5]); a.w = pk2(s[6], s[7]);
    b.x = pk2(s[8], s[9]); b.y = pk2(s[10], s[11]); b.z = pk2(s[12], s[13]); b.w = pk2(s[14], s[15]);
    const bf16x8 p0 = __builtin_bit_cast(bf16x8, a), p1 = __builtin_bit_cast(bf16x8, b);
#pragma unroll
    for (int dt = 0; dt < 4; ++dt) { o[dt] = mfma32(vf[dt * 2], p0, o[dt]); o[dt] = mfma32(vf[dt * 2 + 1], p1, o[dt]); }
#pragma unroll
    for (int f = 0; f < 8; ++f) vf[f] = ldfrag(Vt + ktn * 4096 + f * 512);
  }
}
template <bool CAUSAL>
DI void attn_unit_lds(const bf16x8 (&qf)[8], const LAS bf16_t* Kt, const LAS bf16_t* Vt, const int nkt, float cs, const int qpos, const int hh, f32x16 (&o)[4], float& lsum) {
  f32x16 zero;
#pragma unroll
  for (int i = 0; i < 16; ++i) zero[i] = 0.f;
  const f32x2 sc2 = {ATT_SC, ATT_SC}, cs2 = {cs, cs};
  f32x2 l2 = {0.f, 0.f};
#pragma unroll 1
  for (int kt = 0; kt < nkt; ++kt) {
    f32x16 s = mfma32(*(const LAS bf16x8*)(Kt + kt * 4096), qf[0], zero);
#pragma unroll
    for (int ks = 1; ks < 8; ++ks) { const bf16x8 kf = *(const LAS bf16x8*)(Kt + kt * 4096 + ks * 512); s = mfma32(kf, qf[ks], s); }
    u32x4 a, b;
    unsigned pk[8];
#pragma unroll
    for (int i = 0; i < 8; ++i) {
      f32x2 t = {s[2 * i], s[2 * i + 1]};
      t = t * sc2 - cs2;
      t.x = __builtin_amdgcn_exp2f(t.x); t.y = __builtin_amdgcn_exp2f(t.y);
      if (CAUSAL) {
        if (kt * 32 + crow(2 * i, hh) > qpos) t.x = 0.f;
        if (kt * 32 + crow(2 * i + 1, hh) > qpos) t.y = 0.f;
      }
      l2 += t;
      pk[i] = pk2(t.x, t.y);
    }
    a.x = pk[0]; a.y = pk[1]; a.z = pk[2]; a.w = pk[3]; b.x = pk[4]; b.y = pk[5]; b.z = pk[6]; b.w = pk[7];
    const bf16x8 p0 = __builtin_bit_cast(bf16x8, a), p1 = __builtin_bit_cast(bf16x8, b);
#pragma unroll
    for (int dt = 0; dt < 4; ++dt) {
      const bf16x8 v0 = *(const LAS bf16x8*)(Vt + kt * 4096 + dt * 1024), v1 = *(const LAS bf16x8*)(Vt + kt * 4096 + dt * 1024 + 512);
      o[dt] = mfma32(v0, p0, o[dt]); o[dt] = mfma32(v1, p1, o[dt]);
    }
  }
  lsum += l2.x + l2.y;
}
DI float kmax_norm(const float* kmax2_bh) {
  float m = 0.f;
#pragma unroll
  for (int k = 0; k < 32; ++k) m = fmaxf(m, kmax2_bh[k]);
  return sqrtf(m);
}
DI float qf_norm2(const bf16x8 (&qf)[8]) {
  float n2 = 0.f;
#pragma unroll
  for (int ks = 0; ks < 8; ++ks) {
    const u32x4 u = __builtin_bit_cast(u32x4, qf[ks]);
    n2 += bf_lo(u.x) * bf_lo(u.x) + bf_hi(u.x) * bf_hi(u.x) + bf_lo(u.y) * bf_lo(u.y) + bf_hi(u.y) * bf_hi(u.y)
        + bf_lo(u.z) * bf_lo(u.z) + bf_hi(u.z) * bf_hi(u.z) + bf_lo(u.w) * bf_lo(u.w) + bf_hi(u.w) * bf_hi(u.w);
  }
  n2 += __shfl_xor(n2, 32);
  return n2;
}
struct T3 { float v1, v2, v3; int i1, i2, i3; };
DI bool t3_better(float v, int b, float w, int j) { return v > w || (v == w && b < j); }
DI T3 top3_insert(T3 t, float v, int blk) {
  const bool g1 = t3_better(v, blk, t.v1, t.i1), g2 = t3_better(v, blk, t.v2, t.i2), g3 = t3_better(v, blk, t.v3, t.i3);
  T3 r;
  r.v3 = g2 ? t.v2 : (g3 ? v : t.v3); r.i3 = g2 ? t.i2 : (g3 ? blk : t.i3);
  r.v2 = g1 ? t.v1 : (g2 ? v : t.v2); r.i2 = g1 ? t.i1 : (g2 ? blk : t.i2);
  r.v1 = g1 ? v : t.v1;               r.i1 = g1 ? blk : t.i1;
  return r;
}

constexpr int MB_K = 0, MB_V = 65536, MB_PRE = 131072, MB_END = MB_PRE + 768 * 4;
DI void stage_kv_block(const int tid, const bf16_t* kblk, const bf16_t* vblk, LAS char* lds) {
  const u32x4* ksrc = (const u32x4*)kblk; const u32x4* vsrc = (const u32x4*)vblk;
  u32x4 kk[8];
#pragma unroll
  for (int i = 0; i < 8; ++i) kk[i] = ksrc[tid + 512 * i];
#pragma unroll
  for (int i = 0; i < 8; ++i) *(LAS u32x4*)(lds + MB_K + (tid + 512 * i) * 16) = kk[i];
  __builtin_amdgcn_sched_barrier(0);
#pragma unroll
  for (int i = 0; i < 8; ++i) kk[i] = vsrc[tid + 512 * i];
#pragma unroll
  for (int i = 0; i < 8; ++i) *(LAS u32x4*)(lds + MB_V + (tid + 512 * i) * 16) = kk[i];
  __builtin_amdgcn_sched_barrier(0);
}
constexpr int MA_CNT = 131072, MA_BASE = MA_CNT + 128, MA_LIST = MA_CNT + 256, MA_END = MA_LIST + 32 * 256 * 2;
DI void store_partial(bf16_t* po, const f32x16 (&o)[4], const int hh) {
#pragma unroll
  for (int dt = 0; dt < 4; ++dt)
#pragma unroll
    for (int i4 = 0; i4 < 4; i4 += 2) {
      f32x4 v, u;
      v[0] = o[dt][4 * i4 + 0]; v[1] = o[dt][4 * i4 + 1]; v[2] = o[dt][4 * i4 + 2]; v[3] = o[dt][4 * i4 + 3];
      u[0] = o[dt][4 * i4 + 4]; u[1] = o[dt][4 * i4 + 5]; u[2] = o[dt][4 * i4 + 6]; u[3] = o[dt][4 * i4 + 7];
      *(u32x4*)(po + dt * 32 + 8 * i4 + 8 * hh) = widen32_pair(pk4(v), pk4(u));
    }
}
DI float* pl_ptr(char* ws, size_t bhq, int slot) { return (float*)(ws + OFF_PL4) + bhq * 4 + slot; }
DI bf16_t* po_slot(char* ws, int slot) { return (bf16_t*)(ws + (slot < 2 ? OFF_PO01 : OFF_PO2)) + (slot < 2 ? (size_t)slot * 24 * SEQ * 128 : 0); }

DI void moba_a_item(const int tid_, const Params& p, LAS char* lds, int item) {
  char* ws = p.ws;
  const int tid = launder(tid_);
  const int w = tid >> 6, lane = tid & 63, r = lane & 31, hh = lane >> 5;
  const int ob = item & 31, bh = item >> 5, h = bh % 6, b = bh / 6;
  LAS int* cnt = (LAS int*)(lds + MA_CNT);
  LAS int* gbase = (LAS int*)(lds + MA_BASE);
  LAS unsigned short* lists = (LAS unsigned short*)(lds + MA_LIST);
  const bf16_t* Q = (const bf16_t*)(ws + OFF_Q);
  const int tokbase = b * SEQ + ob * 256;
  __syncthreads();
  if (tid < 32) cnt[tid] = 0;
  __syncthreads();
  bf16x8 qf[8];
  {
    const bf16_t* qrow = Q + (size_t)(tokbase + 32 * w + r) * AW + h * 128 + 8 * hh;
#pragma unroll
    for (int ks = 0; ks < 8; ++ks) qf[ks] = *(const bf16x8*)(qrow + 16 * ks);
  }
  const float kmaxn = kmax_norm((const float*)(ws + OFF_KMAX2) + bh * 32);
  const float cs_own = sqrtf(qf_norm2(qf)) * kmaxn * ATT_SC;
  if (ob > 0) {
    f32x16 sc;
#pragma unroll
    for (int i = 0; i < 16; ++i) sc[i] = 0.f;
    const bf16_t* kmh = (const bf16_t*)(ws + OFF_KMEAN) + (size_t)bh * 4096 + lane * 8;
#pragma unroll
    for (int ks = 0; ks < 8; ++ks) {
      sc = mfma32(*(const bf16x8*)(kmh + ks * 512), qf[ks], sc);
      sc = mfma32(*(const bf16x8*)(kmh + 98304 + ks * 512), qf[ks], sc);
    }
    T3 t; t.v1 = t.v2 = t.v3 = -INFINITY; t.i1 = t.i2 = t.i3 = 999;
#pragma unroll
    for (int i = 0; i < 16; ++i) { const int blk = crow(i, hh); const bool ok = blk < ob; t = top3_insert(t, ok ? sc[i] : -INFINITY, ok ? blk : 1000); }
    T3 q;
    q.v1 = __shfl_xor(t.v1, 32); q.v2 = __shfl_xor(t.v2, 32); q.v3 = __shfl_xor(t.v3, 32);
    q.i1 = __shfl_xor(t.i1, 32); q.i2 = __shfl_xor(t.i2, 32); q.i3 = __shfl_xor(t.i3, 32);
    t = top3_insert(t, q.v1, q.i1); t = top3_insert(t, q.v2, q.i2); t = top3_insert(t, q.v3, q.i3);
    if (hh == 0) {
      const unsigned qa = (unsigned)(ob * 256 + 32 * w + r) << 2;
      if (t.i1 < 32) { const int sl = atomicAdd((int*)(cnt + t.i1), 1); lists[t.i1 * 256 + sl] = (unsigned short)(qa | 0u); }
      if (t.i2 < 32) { const int sl = atomicAdd((int*)(cnt + t.i2), 1); lists[t.i2 * 256 + sl] = (unsigned short)(qa | 1u); }
      if (t.i3 < 32) { const int sl = atomicAdd((int*)(cnt + t.i3), 1); lists[t.i3 * 256 + sl] = (unsigned short)(qa | 2u); }
    }
  }
  __syncthreads();
  if (tid < ob) { const int n = cnt[tid]; gbase[tid] = n ? (int)atomicAdd((unsigned*)(ws + OFF_GCNT) + bh * 32 + tid, (unsigned)n) : 0; }
  __syncthreads();
  {
    unsigned short* gl = (unsigned short*)(ws + OFF_GLIST) + (size_t)bh * 32 * SEQ;
    for (int j = 0; j < ob; ++j) { if (tid < cnt[j]) gl[(size_t)j * SEQ + gbase[j] + tid] = lists[j * 256 + tid]; }
  }
  {
    f32x16 o[4]; float ls = 0.f;
#pragma unroll
    for (int dt = 0; dt < 4; ++dt)
#pragma unroll
      for (int i = 0; i < 16; ++i) o[dt][i] = 0.f;
    const size_t boff = ((size_t)bh * 256 + ob * 8) * 4096;
    stage_kv_block(tid, (const bf16_t*)(ws + OFF_K) + boff, (const bf16_t*)(ws + OFF_VT) + boff, lds);
    __syncthreads();
    attn_unit_lds<true>(qf, (const LAS bf16_t*)(lds + MB_K) + lane * 8, (const LAS bf16_t*)(lds + MB_V) + lane * 8, w + 1, cs_own, 32 * w + r, hh, o, ls);
    ls += __shfl_xor(ls, 32);
    store_partial((bf16_t*)((char*)p.out + DO_OA) + (size_t)(tokbase + 32 * w + r) * AW + h * 128, o, hh);
    if (hh == 0) *pl_ptr(ws, (size_t)bh * SEQ + ob * 256 + 32 * w + r, 3) = ls;
  }
}

static_assert(MB_END <= LDS_BYTES && MA_END <= LDS_BYTES, "lds");
DI void phase3b(const Params& p, LAS char* lds, const int wv) {
  char* ws = p.ws;
  const int tid0 = make_tid(wv);
  LAS int* pre = (LAS int*)(lds + MB_PRE);
  const unsigned* gcnt = (const unsigned*)(ws + OFF_GCNT);
  __syncthreads();
  {
    const int tid = tid0, w = tid >> 6, lane = tid & 63;
    int c0 = 0, c1 = 0;
    if (tid < 384) { c0 = ((int)gcnt[2 * tid] + 255) >> 8; c1 = ((int)gcnt[2 * tid + 1] + 255) >> 8; }
    int incl = c0 + c1;
#pragma unroll
    for (int d = 1; d < 64; d <<= 1) { const int t = __shfl_up(incl, d); if (lane >= d) incl += t; }
    LAS int* wsum = pre + 768 - 8;
    __syncthreads();
    if (lane == 63) wsum[w] = incl;
    __syncthreads();
    int woff = 0;
    for (int k = 0; k < w; ++k) woff += wsum[k];
    __syncthreads();
    if (tid < 384) { pre[2 * tid] = woff + incl - c1; pre[2 * tid + 1] = woff + incl; }
    __syncthreads();
  }
  const int total = __builtin_amdgcn_readfirstlane(pre[767]);
  const float* kmax2 = (const float*)(ws + OFF_KMAX2);
  const int vblk = ((gridDim.x & 7) == 0) ? (int)((blockIdx.x & 7) * (gridDim.x >> 3) + (blockIdx.x >> 3)) : (int)blockIdx.x;
  const int u_lo = (int)(((long long)vblk * total) / (int)gridDim.x), u_hi = (int)(((long long)(vblk + 1) * total) / (int)gridDim.x);
  int prev_pair = -1;
  for (int u = u_lo; u < u_hi; ++u) {
    const int tid = launder(tid0), w = tid >> 6, lane = tid & 63, r = lane & 31, hh = lane >> 5;
    int lo = 0, hi = 767;
    while (lo < hi) { const int mid = (lo + hi) >> 1; if (pre[mid] > u) hi = mid; else lo = mid + 1; }
    const int pair = __builtin_amdgcn_readfirstlane(lo), bh = pair >> 5, j = pair & 31, h = bh % 6, b = bh / 6;
    const int chunk = __builtin_amdgcn_readfirstlane(u - (pair ? pre[pair - 1] : 0));
    const int n = __builtin_amdgcn_readfirstlane((int)gcnt[pair]);
    if (pair != prev_pair) {
      __syncthreads();
      stage_kv_block(tid, (const bf16_t*)(ws + OFF_K) + ((size_t)bh * 256 + j * 8) * 4096, (const bf16_t*)(ws + OFF_VT) + ((size_t)bh * 256 + j * 8) * 4096, lds);
      __syncthreads();
      prev_pair = pair;
    }
    const int idx = (chunk * 8 + w) * 32 + r;
    if ((chunk * 8 + w) * 32 < n) {
      const unsigned short* gl = (const unsigned short*)(ws + OFF_GLIST) + ((size_t)bh * 32 + j) * SEQ;
      const bool valid = idx < n;
      const unsigned e = gl[valid ? idx : n - 1];
      const int qa = (int)(e >> 2), slot = (int)(e & 3u);
      bf16x8 qf[8];
      {
        const bf16_t* qrow = (const bf16_t*)(ws + OFF_Q) + (size_t)(b * SEQ + qa) * AW + h * 128 + 8 * hh;
#pragma unroll
        for (int ks = 0; ks < 8; ++ks) qf[ks] = *(const bf16x8*)(qrow + 16 * ks);
      }
      const float kmaxn = kmax_norm(kmax2 + bh * 32);
      const float cs = sqrtf(qf_norm2(qf)) * kmaxn * ATT_SC;
      f32x16 o[4]; float ls = 0.f;
#pragma unroll
      for (int dt = 0; dt < 4; ++dt)
#pragma unroll
        for (int i = 0; i < 16; ++i) o[dt][i] = 0.f;
      attn_unit_lds<false>(qf, (const LAS bf16_t*)(lds + MB_K) + lane * 8, (const LAS bf16_t*)(lds + MB_V) + lane * 8, 8, cs, 1 << 30, hh, o, ls);
      ls += __shfl_xor(ls, 32);
      if (valid) {
        store_partial(po_slot(ws, slot) + ((size_t)bh * SEQ + qa) * 128, o, hh);
        if (hh == 0) *pl_ptr(ws, (size_t)bh * SEQ + qa, slot) = ls;
      }
    }
  }
  __syncthreads();
}

DI void phase3c(const Params& p, const int wv) {
  char* ws = p.ws;
  const size_t gt = (size_t)blockIdx.x * NTHREADS + make_tid(wv), NGT = (size_t)gridDim.x * NTHREADS;
  bf16_t* OA = (bf16_t*)((char*)p.out + DO_OA);
  const bf16_t* GA = (const bf16_t*)(ws + OFF_GA);
  const bf16_t* P0 = po_slot(ws, 0); const bf16_t* P1 = po_slot(ws, 1); const bf16_t* P2 = po_slot(ws, 2);
  const f32x4* L4 = (const f32x4*)(ws + OFF_PL4);
  const size_t N = (size_t)MTOK * 6 * 16;
  for (size_t base = gt; base < N; base += NGT * 4) {
    u32x4 vo[4], v0[4], v1[4], v2[4], vg[4]; f32x4 l4[4]; size_t oo[4]; int ns[4];
#pragma unroll
    for (int k = 0; k < 4; ++k) {
      const size_t i0 = base + k * NGT, i = i0 < N ? i0 : gt;
      const int c8 = (int)(i & 15), h = (int)((i >> 4) % 6), tok = (int)((i >> 4) / 6);
      const int b = tok >> 13, q = tok & (SEQ - 1), bh = b * 6 + h;
      ns[k] = min(q >> 8, 3);
      oo[k] = (size_t)tok * AW + h * 128 + c8 * 8;
      const size_t poff = ((size_t)bh * SEQ + q) * 128 + c8 * 8, loff = (size_t)bh * SEQ + q;
      vo[k] = *(const u32x4*)(OA + oo[k]); vg[k] = *(const u32x4*)(GA + oo[k]);
      v0[k] = *(const u32x4*)(P0 + poff); v1[k] = *(const u32x4*)(P1 + poff); v2[k] = *(const u32x4*)(P2 + poff);
      l4[k] = L4[loff];
    }
#pragma unroll
    for (int k = 0; k < 4; ++k) {
      if (base + k * NGT < N) {
        const bool s0 = ns[k] > 0, s1 = ns[k] > 1, s2 = ns[k] > 2;
        const u32x4 a = vo[k], b0 = v0[k], b1 = v1[k], b2 = v2[k], g = vg[k];
        float acc[8] = {bf_lo(a.x), bf_hi(a.x), bf_lo(a.y), bf_hi(a.y), bf_lo(a.z), bf_hi(a.z), bf_lo(a.w), bf_hi(a.w)};
        const float f0[8] = {bf_lo(b0.x), bf_hi(b0.x), bf_lo(b0.y), bf_hi(b0.y), bf_lo(b0.z), bf_hi(b0.z), bf_lo(b0.w), bf_hi(b0.w)};
        const float f1[8] = {bf_lo(b1.x), bf_hi(b1.x), bf_lo(b1.y), bf_hi(b1.y), bf_lo(b1.z), bf_hi(b1.z), bf_lo(b1.w), bf_hi(b1.w)};
        const float f2[8] = {bf_lo(b2.x), bf_hi(b2.x), bf_lo(b2.y), bf_hi(b2.y), bf_lo(b2.z), bf_hi(b2.z), bf_lo(b2.w), bf_hi(b2.w)};
#pragma unroll
        for (int e = 0; e < 8; ++e) acc[e] += (s0 ? f0[e] : 0.f) + (s1 ? f1[e] : 0.f) + (s2 ? f2[e] : 0.f);
        const float l = l4[k][3] + (s0 ? l4[k][0] : 0.f) + (s1 ? l4[k][1] : 0.f) + (s2 ? l4[k][2] : 0.f);
        const float inv = __builtin_amdgcn_rcpf(l);
        u32x4 o;
        o.x = pk2(acc[0] * inv * bf_lo(g.x), acc[1] * inv * bf_hi(g.x)); o.y = pk2(acc[2] * inv * bf_lo(g.y), acc[3] * inv * bf_hi(g.y));
        o.z = pk2(acc[4] * inv * bf_lo(g.z), acc[5] * inv * bf_hi(g.z)); o.w = pk2(acc[6] * inv * bf_lo(g.w), acc[7] * inv * bf_hi(g.w));
        *(u32x4*)(OA + oo[k]) = o;
      }
    }
  }
}

DI void xattn_pair(const int tid_, const Params& p, LAS char* lds, int bhd, int qt0) {
  char* ws = p.ws;
  const int tid = launder(tid_);
  const int w = tid >> 6, lane = tid & 63, r = lane & 31, hh = lane >> 5;
  const int hd = bhd & 3, b = bhd >> 2;
  __syncthreads();
  stage_kv_block(tid, (const bf16_t*)(ws + OFF_MEMK) + (size_t)bhd * 8 * 4096, (const bf16_t*)(ws + OFF_MEMVT) + (size_t)bhd * 8 * 4096, lds);
  __syncthreads();
  const float kmaxn = sqrtf(((const float*)(ws + OFF_MKMAX2))[bhd]);
#pragma unroll 1
  for (int i = 0; i < 2; ++i) {
    const int tok = b * SEQ + (qt0 + i) * 256 + 32 * w + r;
    bf16x8 qf[8];
    {
      const bf16_t* qrow = (const bf16_t*)(ws + OFF_QC) + (size_t)tok * CW + hd * 128 + 8 * hh;
#pragma unroll
      for (int ks = 0; ks < 8; ++ks) qf[ks] = *(const bf16x8*)(qrow + 16 * ks);
    }
    const float cs = sqrtf(qf_norm2(qf)) * kmaxn * ATT_SC;
    f32x16 o[4]; float ls = 0.f;
#pragma unroll
    for (int dt = 0; dt < 4; ++dt)
#pragma unroll
      for (int k = 0; k < 16; ++k) o[dt][k] = 0.f;
    attn_unit_lds<false>(qf, (const LAS bf16_t*)(lds + MB_K) + lane * 8, (const LAS bf16_t*)(lds + MB_V) + lane * 8, 8, cs, 1 << 30, hh, o, ls);
    ls += __shfl_xor(ls, 32);
    const float inv = __builtin_amdgcn_rcpf(ls);
    const bf16_t* gc = (const bf16_t*)(ws + OFF_GC) + (size_t)tok * CW + hd * 128 + 8 * hh;
    bf16_t* oc = (bf16_t*)((char*)p.out + DO_OC) + (size_t)tok * CW + hd * 128 + 8 * hh;
#pragma unroll
    for (int dt = 0; dt < 4; ++dt)
#pragma unroll
      for (int i4 = 0; i4 < 4; i4 += 2) {
        u32x2 ga, gb; unwiden32_pair(*(const u32x4*)(gc + dt * 32 + 8 * i4), ga, gb);
        f32x4 v, u;
        v[0] = o[dt][4 * i4 + 0] * inv * bf_lo(ga.x); v[1] = o[dt][4 * i4 + 1] * inv * bf_hi(ga.x);
        v[2] = o[dt][4 * i4 + 2] * inv * bf_lo(ga.y); v[3] = o[dt][4 * i4 + 3] * inv * bf_hi(ga.y);
        u[0] = o[dt][4 * i4 + 4] * inv * bf_lo(gb.x); u[1] = o[dt][4 * i4 + 5] * inv * bf_hi(gb.x);
        u[2] = o[dt][4 * i4 + 6] * inv * bf_lo(gb.y); u[3] = o[dt][4 * i4 + 7] * inv * bf_hi(gb.y);
        *(u32x4*)(oc + dt * 32 + 8 * i4) = widen32_pair(pk4(v), pk4(u));
      }
  }
}
DI void xattn_item(const int tid, const Params& p, int item) {
  char* ws = p.ws;
  const int w = tid >> 6, lane = tid & 63, r = lane & 31, hh = lane >> 5;
  const int qt = item & 31, bhd = item >> 5, hd = bhd & 3, b = bhd >> 2;
  const int tok = b * SEQ + qt * 256 + 32 * w + r;
  bf16x8 qf[8];
  {
    const bf16_t* qrow = (const bf16_t*)(ws + OFF_QC) + (size_t)tok * CW + hd * 128 + 8 * hh;
#pragma unroll
    for (int ks = 0; ks < 8; ++ks) qf[ks] = *(const bf16x8*)(qrow + 16 * ks);
  }
  const float kmaxn = sqrtf(((const float*)(ws + OFF_MKMAX2))[b * 4 + hd]);
  const float cs = sqrtf(qf_norm2(qf)) * kmaxn * ATT_SC;
  f32x16 o[4]; float ls = 0.f;
#pragma unroll
  for (int dt = 0; dt < 4; ++dt)
#pragma unroll
    for (int i = 0; i < 16; ++i) o[dt][i] = 0.f;
  const size_t boff = (size_t)bhd * 8 * 4096 + lane * 8;
  attn_unit(qf, (const bf16_t*)(ws + OFF_MEMK) + boff, (const bf16_t*)(ws + OFF_MEMVT) + boff, 8, cs, 1 << 30, hh, o, ls);
  ls += __shfl_xor(ls, 32);
  const float inv = 1.f / ls;
  const bf16_t* gc = (const bf16_t*)(ws + OFF_GC) + (size_t)tok * CW + hd * 128 + 4 * hh;
  bf16_t* oc = (bf16_t*)((char*)p.out + DO_OC) + (size_t)tok * CW + hd * 128 + 4 * hh;
#pragma unroll
  for (int dt = 0; dt < 4; ++dt)
#pragma unroll
    for (int i4 = 0; i4 < 4; ++i4) {
      const u32x2 g = *(const u32x2*)(gc + dt * 32 + 8 * i4);
      f32x4 v;
      v[0] = o[dt][4 * i4 + 0] * inv * bf_lo(g.x); v[1] = o[dt][4 * i4 + 1] * inv * bf_hi(g.x);
      v[2] = o[dt][4 * i4 + 2] * inv * bf_lo(g.y); v[3] = o[dt][4 * i4 + 3] * inv * bf_hi(g.y);
      st4(oc + dt * 32 + 8 * i4, v);
    }
}

DI void phase3a(const Params& p, LAS char* lds, const int wv) {
  const int tid = make_tid(wv);
  if (gridDim.x == 256) {
    const int xcd = blockIdx.x & 7, slot = blockIdx.x >> 3;
    for (int i = 0; i < 3; ++i) {
      const int bh = i * 8 + xcd;
      const int ob = (i == 0) ? slot : (i == 1 ? 31 - slot : ((slot + 16) & 31));
      moba_a_item(tid, p, lds, bh * 32 + ob);
    }
    xattn_pair(tid, p, lds, blockIdx.x >> 4, (blockIdx.x & 15) * 2);
  } else {
    for (int it = blockIdx.x; it < 768 + 512; it += gridDim.x) {
      if (it < 768) moba_a_item(tid, p, lds, it);
      else xattn_item(tid, p, it - 768);
    }
  }
}

DI void tile45(int L, int& tt, int& ct) {
  const int G = gridDim.x, b = blockIdx.x;
  if (G == 256) { const int xcd = b & 7, slot = b >> 3; tt = xcd * 16 + 8 * L + (slot & 7); ct = slot >> 3; }
  else { const int t = L * G + b; tt = t >> 2; ct = t & 3; }
}
struct P4Ops { const bf16_t *A, *B; int ld, K; };
DI P4Ops p4_ops(const Params& p, int tok0, int col0, int s) {
  char* ws = p.ws; P4Ops o;
  if (s == 0) { o.A = (const bf16_t*)(ws + OFF_WA) + (size_t)col0 * AW; o.B = (const bf16_t*)((const char*)p.out + DO_OA) + (size_t)tok0 * AW; o.ld = AW; o.K = AW; }
  else if (s == 1) { o.A = (const bf16_t*)(ws + OFF_WB) + (size_t)col0 * AW; o.B = (const bf16_t*)((const char*)p.out + DO_OB) + (size_t)tok0 * AW; o.ld = AW; o.K = AW; }
  else if (s == 2) { o.A = (const bf16_t*)(ws + OFF_WC) + (size_t)col0 * CW; o.B = (const bf16_t*)((const char*)p.out + DO_OC) + (size_t)tok0 * CW; o.ld = CW; o.K = CW; }
  else { o.A = (const bf16_t*)(ws + OFF_WIN) + (size_t)(6400 + (s - 3) * 1024 + col0) * DM; o.B = (const bf16_t*)(ws + OFF_HB) + (size_t)tok0 * DM; o.ld = DM; o.K = DM; }
  return o;
}
DI void phase4(const Params& p, LAS char* lds, const int wv) {
  char* ws = p.ws;
  const int tid = make_tid(wv);
  const int nL = (gridDim.x == 256) ? 2 : (512 + gridDim.x - 1) / gridDim.x;
  int nvalid = 0;
  for (int L = 0; L < nL; ++L) { int tt, ct; tile45(L, tt, ct); if (tt < 128) nvalid = L + 1; }
  if (nvalid == 0) return;
  { int tt, ct; tile45(0, tt, ct); const P4Ops o = p4_ops(p, tt * 256, ct * 256, 0); gemm_begin(tid, o.A, o.B, o.ld, lds); }
#pragma unroll 1
  for (int u = 0; u < nvalid * 6; ++u) {
    const int L = u / 6, s = u - L * 6;
    int tt, ct; tile45(L, tt, ct);
    const int tok0 = tt * 256, col0 = ct * 256;
    const P4Ops o = p4_ops(p, tok0, col0, s);
    const int un = (u + 1 < nvalid * 6) ? u + 1 : u, Ln = un / 6, sn = un - Ln * 6;
    int t2, c2; tile45(Ln, t2, c2);
    const P4Ops nx = p4_ops(p, t2 * 256, c2 * 256, sn);
    f32x4 acc[2][2][4][2];
    gemm_unit(tid, o.A, o.B, o.ld, o.K, nx.A, nx.B, nx.ld, lds, acc);
    if (s < 3) epi_rowmajor(tid, acc, (bf16_t*)(ws + (s == 0 ? OFF_TA : (s == 1 ? OFF_TB : OFF_TC))), DM, tok0, col0, EP_PLAIN, nullptr);
    else epi_gate(tid, acc, (const bf16_t*)(ws + (s == 3 ? OFF_TA : (s == 4 ? OFF_TB : OFF_TC))), (bf16_t*)(ws + OFF_Y), tok0, col0, s == 3);
  }
  gemm_end(tid);
}
DI void phase5(const Params& p, LAS char* lds, const int wv, float* rowss) {
  char* ws = p.ws;
  const int tid = make_tid(wv);
  const int nL = (gridDim.x == 256) ? 2 : (512 + gridDim.x - 1) / gridDim.x;
  int nvalid = 0;
  for (int L = 0; L < nL; ++L) { int tt, ct; tile45(L, tt, ct); if (tt < 128) nvalid = L + 1; }
  if (nvalid == 0) return;
  const bf16_t* WO = (const bf16_t*)(ws + OFF_WO); const bf16_t* Y = (const bf16_t*)(ws + OFF_Y);
  if (tid == 0) *(LAS unsigned*)(lds + 131072 + 8192) = 0u;
  { int tt, ct; tile45(0, tt, ct); gemm_begin(tid, WO + (size_t)ct * 256 * DM, Y + (size_t)tt * 256 * DM, DM, lds); }
#pragma unroll 1
  for (int L = 0; L < nvalid; ++L) {
    int tt, ct; tile45(L, tt, ct);
    int t2, c2; tile45((L + 1 < nvalid) ? L + 1 : L, t2, c2);
    f32x4 acc[2][2][4][2];
    gemm_unit(tid, WO + (size_t)ct * 256 * DM, Y + (size_t)tt * 256 * DM, DM, DM, WO + (size_t)c2 * 256 * DM, Y + (size_t)t2 * 256 * DM, DM, lds, acc);
    const int wr5 = __builtin_amdgcn_readfirstlane(tid >> 8);
    if (wr5 == 0) G_BAR;
    epi_out_norm(tid, acc, p.x, p.out, rowss, (unsigned*)(ws + OFF_C5) + tt, p.final_g, tt * 256, ct * 256, (LAS unsigned*)(lds + 131072 + 8192));
    if (wr5 == 1) G_BAR;
  }
  gemm_end(tid);
}
DI void phase6(const Params& p, const int wv) {
  const size_t gt = (size_t)blockIdx.x * NTHREADS + make_tid(wv), NGT = (size_t)gridDim.x * NTHREADS;
  const float* rowss = (const float*)(p.ws + OFF_ROWSS);
  const size_t N = (size_t)MTOK * (DM / 4);
  f32x4* out4 = (f32x4*)p.out;
  for (size_t base = gt; base < N; base += NGT * 8) {
    f32x4 z[8]; float ss[8];
#pragma unroll
    for (int k = 0; k < 8; ++k) { const size_t i = base + k * NGT; const size_t ic = i < N ? i : gt; z[k] = out4[ic]; ss[k] = rowss[ic >> 8]; }
#pragma unroll
    for (int k = 0; k < 8; ++k) {
      const size_t i = base + k * NGT;
      if (i < N) {
        const float rs = rsqrtf(ss[k] * (1.f / DM) + 1e-6f);
        const f32x4 g = ((const f32x4*)p.final_g)[i & 255];
        f32x4 o; o[0] = z[k][0] * rs * g[0]; o[1] = z[k][1] * rs * g[1]; o[2] = z[k][2] * rs * g[2]; o[3] = z[k][3] * rs * g[3];
        out4[i] = o;
      }
    }
  }
}

__global__ void __launch_bounds__(NTHREADS) fwd_megakernel(Params p) {
  extern __shared__ __attribute__((aligned(16))) char smem_raw[];
  LAS char* lds = (LAS char*)smem_raw;
  cg::grid_group grid = cg::this_grid();
  const int wv = __builtin_amdgcn_readfirstlane((int)threadIdx.x >> 6);
  for (int rep = 0; rep < REP0; ++rep) phase0(p, lds, wv);
  grid.sync();
  unsigned* bar = (unsigned*)(p.ws + OFF_BAR);
  const unsigned G = gridDim.x;
  for (int rep = 0; rep < REP1; ++rep) phase1(p, lds, wv);
  grid_bar(bar, 1u, make_tid(wv));
  for (int rep = 0; rep < REP2; ++rep) phase2(p, lds, wv);
  grid_bar(bar, 2u, make_tid(wv));
  phase3a(p, lds, wv);
  grid_bar(bar, 3u, make_tid(wv));
  for (int rep = 0; rep < REP3; ++rep) phase3b(p, lds, wv);
  grid_bar(bar, 4u, make_tid(wv));
  phase3c(p, wv);
  grid_bar(bar, 5u, make_tid(wv));
  for (int rep = 0; rep < REP4; ++rep) phase4(p, lds, wv);
  grid_bar(bar, 6u, make_tid(wv));
  phase5(p, lds, wv, (float*)(p.ws + OFF_ROWSS));
}

extern "C" void kernel_launch(void* const* d_in, const int* in_sizes, int n_in,
                              void* d_out, int out_size, void* d_ws, size_t ws_size,
                              hipStream_t stream) {
  static int grid_blocks = 0;
  if (!grid_blocks) {
    int dev = 0, cus = 0, per_cu = 0;
    (void)hipGetDevice(&dev);
    (void)hipDeviceGetAttribute(&cus, hipDeviceAttributeMultiprocessorCount, dev);
    (void)hipFuncSetAttribute((const void*)fwd_megakernel, hipFuncAttributeMaxDynamicSharedMemorySize, LDS_BYTES);
    (void)hipOccupancyMaxActiveBlocksPerMultiprocessor(&per_cu, (const void*)fwd_megakernel, NTHREADS, LDS_BYTES);
    if (per_cu < 1) per_cu = 1;
    grid_blocks = cus * per_cu;
    if (ws_size < WS_END3) fprintf(stderr, "kernel_launch: workspace too small: %zu < %zu\n", ws_size, (size_t)WS_END3);
  }
  Params p{};
  p.x = (const float*)d_in[0]; p.mem = (const float*)d_in[1]; p.norm_g = (const float*)d_in[2]; p.mem_norm_g = (const float*)d_in[3];
  p.final_g = (const float*)d_in[4]; p.w_in = (const float*)d_in[5]; p.w_mkv = (const float*)d_in[6]; p.ln_g = (const float*)d_in[7];
  p.w_sp = (const float*)d_in[8]; p.b_sp = (const float*)d_in[9]; p.w_a = (const float*)d_in[10]; p.w_b = (const float*)d_in[11];
  p.w_c = (const float*)d_in[12]; p.w_out = (const float*)d_in[13];
  p.out = (float*)d_out; p.ws = (char*)d_ws;
  void* args[] = {&p};
  hipError_t e = hipLaunchCooperativeKernel((void*)fwd_megakernel, dim3(grid_blocks), dim3(NTHREADS), args, LDS_BYTES, stream);
  if (e != hipSuccess) fprintf(stderr, "cooperative launch failed: %s (grid %d)\n", hipGetErrorString(e), grid_blocks);
}
```

```cpp
#include <hip/hip_runtime.h>
#include <hip/hip_cooperative_groups.h>
#include <cstdio>
#include <cstdint>
namespace cg = cooperative_groups;

#define LAS __attribute__((address_space(3)))
#define DI __device__ __forceinline__

typedef unsigned short bf16_t;
typedef short bf16x8 __attribute__((ext_vector_type(8)));
typedef float f32x2 __attribute__((ext_vector_type(2)));
typedef float f32x4 __attribute__((ext_vector_type(4)));
typedef float f32x16 __attribute__((ext_vector_type(16)));
typedef __bf16 bf16x2_t __attribute__((ext_vector_type(2)));
typedef unsigned u32x2 __attribute__((ext_vector_type(2)));
typedef unsigned u32x4 __attribute__((ext_vector_type(4)));

#define REP0 1
#define REP1 1
#define REP2 1
#define REP2G 1
#define REP3 1
#define REP4 1
#define REP5 1
constexpr int DM = 1024, NB = 4, SEQ = 8192, MTOK = NB * SEQ;
constexpr int AW = 768, CW = 512, INW = 9472;
constexpr int NTHREADS = 512;
constexpr int LDS_BYTES = 152 * 1024;

constexpr size_t MiB = 1u << 20;
constexpr size_t OFF_ROWSS = 0;
constexpr size_t OFF_KMEAN = 131072;
constexpr size_t OFF_KMAX2 = 524288;
constexpr size_t OFF_MKMAX2 = 528384;
constexpr size_t OFF_BAR = 528384 + 1024;
constexpr size_t OFF_GCNT = 528384 + 2048;
constexpr size_t OFF_C5 = 528384 + 2048 + 3072;
constexpr size_t OFF_ROPE = 1 * MiB;
constexpr size_t OFF_HB = 2 * MiB;
constexpr size_t OFF_WIN = 66 * MiB;
constexpr size_t OFF_WMKV = OFF_WIN + (size_t)INW * 1024 * 2;
constexpr size_t OFF_WA = OFF_WMKV + 2 * MiB;
constexpr size_t OFF_WB = OFF_WA + 1536 * 1024;
constexpr size_t OFF_WC = OFF_WB + 1536 * 1024;
constexpr size_t OFF_WO = OFF_WC + 1 * MiB;
constexpr size_t OFF_MEMN = OFF_WO + 2 * MiB;
constexpr size_t OFF_MEMK = OFF_MEMN + 2 * MiB;
constexpr size_t OFF_MEMVT = OFF_MEMK + 1 * MiB;
constexpr size_t OFF_REG = 97 * MiB;
constexpr size_t OFF_Q = OFF_REG;
constexpr size_t OFF_K = OFF_REG + 48 * MiB;
constexpr size_t OFF_VT = OFF_REG + 96 * MiB;
constexpr size_t OFF_VBT = OFF_REG + 144 * MiB;
constexpr size_t OFF_GB = OFF_REG + 192 * MiB;
constexpr size_t OFF_QC = OFF_REG + 240 * MiB;
constexpr size_t OFF_GA = OFF_REG + 272 * MiB;
constexpr size_t OFF_UB = OFF_REG + 320 * MiB;
constexpr size_t OFF_GC = OFF_REG + 368 * MiB;
constexpr size_t WS_END = OFF_REG + 400 * MiB;
constexpr size_t OFF_GLIST = OFF_WIN;
constexpr size_t WS_END2 = WS_END;
static_assert(12 * MiB <= (size_t)6400 * 1024 * 2, "query lists must fit the dead part of the input-projection weights");
constexpr size_t OFF_PO01 = OFF_VBT, OFF_PO2 = OFF_UB;
constexpr size_t OFF_PL01 = OFF_WMKV, OFF_PL23 = OFF_MEMN;
constexpr size_t OFF_PL4 = WS_END2; constexpr size_t WS_END3 = WS_END2 + 3 * MiB;
constexpr size_t OFF_TA = OFF_REG;
constexpr size_t OFF_TB = OFF_REG + 64 * MiB;
constexpr size_t OFF_TC = OFF_REG + 128 * MiB;
constexpr size_t OFF_Y = OFF_REG + 192 * MiB;
static_assert(OFF_MEMVT + 1 * MiB <= OFF_REG, "ws map");
constexpr size_t DO_OA = 0, DO_OC = 48 * MiB, DO_OB = 80 * MiB;

struct Params {
  const float *x, *mem, *norm_g, *mem_norm_g, *final_g, *w_in, *w_mkv, *ln_g, *w_sp, *b_sp, *w_a, *w_b, *w_c, *w_out;
  float* out; char* ws;
};

DI unsigned pk2(float lo, float hi) { f32x2 v = {lo, hi}; return __builtin_bit_cast(unsigned, __builtin_convertvector(v, bf16x2_t)); }
DI float bf_lo(unsigned u) { return __uint_as_float(u << 16); }
DI float bf_hi(unsigned u) { return __uint_as_float(u & 0xffff0000u); }
DI float wave_sum(float v) {
#pragma unroll
  for (int o = 1; o < 64; o <<= 1) v += __shfl_xor(v, o);
  return v;
}
DI float wave_max(float v) {
#pragma unroll
  for (int o = 1; o < 64; o <<= 1) v = fmaxf(v, __shfl_xor(v, o));
  return v;
}
DI float silu_f(float v) { return v * __builtin_amdgcn_rcpf(1.f + __expf(-v)); }
DI float sigmoid_f(float v) { return __builtin_amdgcn_rcpf(1.f + __expf(-v)); }
DI f32x16 mfma32(bf16x8 a, bf16x8 b, f32x16 c) { return __builtin_amdgcn_mfma_f32_32x32x16_bf16(a, b, c, 0, 0, 0); }
DI int crow(int i, int hh) { return (i & 3) + 8 * (i >> 2) + 4 * hh; }
DI int launder(int v) { asm volatile("" : "+v"(v)); return v; }
DI int make_tid(const int wv) { int l; asm volatile("v_mbcnt_lo_u32_b32 %0, -1, 0\n\tv_mbcnt_hi_u32_b32 %0, -1, %0" : "=v"(l)); return wv * 64 + l; }
DI void lds_wait() { asm volatile("s_waitcnt lgkmcnt(0)" ::: "memory"); }

DI void grid_bar(unsigned* ctr, unsigned k, const int tid) {
  __syncthreads();
  if (tid == 0) {
    const unsigned g = blockIdx.x & 7u, gsz = (gridDim.x - g + 7u) >> 3, ngrp = gridDim.x < 8u ? gridDim.x : 8u;
    __builtin_amdgcn_fence(__ATOMIC_RELEASE, "agent");
    const unsigned old = __hip_atomic_fetch_add(ctr + 16 + 16 * g, 1u, __ATOMIC_RELAXED, __HIP_MEMORY_SCOPE_AGENT);
    if (old + 1u == gsz * k) __hip_atomic_fetch_add(ctr, 1u, __ATOMIC_RELAXED, __HIP_MEMORY_SCOPE_AGENT);
    while (__hip_atomic_load(ctr, __ATOMIC_RELAXED, __HIP_MEMORY_SCOPE_AGENT) < ngrp * k) __builtin_amdgcn_s_sleep(2);
    __builtin_amdgcn_fence(__ATOMIC_ACQUIRE, "agent");
  }
  __syncthreads();
}

constexpr int BK = 64, HALF = 128, HTB = HALF * BK * 2;
DI int lds_byte(int r, int c) { int st = (r >> 4) * 2 + (c >> 5), rr = r & 15, cc = c & 31, ob = rr * 64 + cc * 2; return st * 1024 + (ob ^ (((ob >> 9) & 1) << 5)); }
DI void stage_rc(int b, int& R, int& C) { int st = b / 1024, sb = b % 1024, swz = sb ^ (((sb >> 9) & 1) << 5); R = (st >> 1) * 16 + swz / 64; C = (st & 1) * 32 + (swz % 64) / 2; }

DI void gemm_tile(const int tid, const bf16_t* A, const bf16_t* Bm, const int ld, int K, LAS char* lds, f32x4 (&acc)[2][2][4][2]) {
  const int wid = __builtin_amdgcn_readfirstlane(tid >> 6), lane = tid & 63, wr = wid >> 2, wc = wid & 3, fr = lane & 15, fq = lane >> 4;
  unsigned voffA[2];
#pragma unroll
  for (int i = 0; i < 2; ++i) { int R, C; stage_rc(tid * 16 + i * 8192, R, C); voffA[i] = (unsigned)(R * ld + C) * 2u; }
#define voffB voffA
  const unsigned ldsw = (unsigned)wid * 1024u;
  const int aoff = lds_byte(wr * 64 + fr, fq * 8), boff = lds_byte(wc * 32 + fr, fq * 8);
  const char* cA0 = (const char*)A; const char* cA1 = cA0 + (size_t)HALF * ld * 2;
  const char* cB0 = (const char*)Bm; const char* cB1 = cB0 + (size_t)HALF * ld * 2;
#define G_SA(b, h) (((b) * 2 + (h)) * HTB)
#define G_SB(b, h) ((4 + (b) * 2 + (h)) * HTB)
#define G_STAGE(bufoff, gbase, voff, kt) do { _Pragma("unroll") for (int _i = 0; _i < 2; ++_i) \
    __builtin_amdgcn_global_load_lds((const unsigned*)((gbase) + (size_t)(kt) * (BK * 2) + (voff)[_i]), (LAS unsigned*)(lds + (bufoff) + ldsw + _i * 8192), 16, 0, 0); } while (0)
#define G_LDA(dst, b, h) do { _Pragma("unroll") for (int m = 0; m < 4; ++m) _Pragma("unroll") for (int k = 0; k < 2; ++k) dst[m][k] = *(const LAS bf16x8*)(lds + G_SA(b, h) + aoff + m * 2048 + k * 1024); } while (0)
#define G_LDB(dst, b, h) do { _Pragma("unroll") for (int n = 0; n < 2; ++n) _Pragma("unroll") for (int k = 0; k < 2; ++k) dst[n][k] = *(const LAS bf16x8*)(lds + G_SB(b, h) + boff + n * 2048 + k * 1024); } while (0)
#define G_MMA(ai, bj, At, Bt) do { __builtin_amdgcn_s_setprio(1); _Pragma("unroll") for (int m = 0; m < 4; ++m) _Pragma("unroll") for (int n = 0; n < 2; ++n) _Pragma("unroll") for (int k = 0; k < 2; ++k) \
    acc[ai][bj][m][n] = __builtin_amdgcn_mfma_f32_16x16x32_bf16(At[m][k], Bt[n][k], acc[ai][bj][m][n], 0, 0, 0); __builtin_amdgcn_s_setprio(0); } while (0)
#define G_WAIT_V(n) asm volatile("s_waitcnt vmcnt(" #n ")" ::: "memory")
#define G_WAIT_L(n) asm volatile("s_waitcnt lgkmcnt(" #n ")" ::: "memory")
#define G_BAR __builtin_amdgcn_s_barrier()
#define G_SCHED __builtin_amdgcn_sched_barrier(0)
#pragma unroll
  for (int a = 0; a < 2; ++a)
#pragma unroll
    for (int b = 0; b < 2; ++b)
#pragma unroll
      for (int m = 0; m < 4; ++m)
#pragma unroll
        for (int n = 0; n < 2; ++n) acc[a][b][m][n] = (f32x4){0.f, 0.f, 0.f, 0.f};
  bf16x8 At[4][2], B0[2][2], B1[2][2];
  const int nt = K / BK;
  G_WAIT_V(0); G_WAIT_L(0); __syncthreads();
  G_STAGE(G_SB(0, 0), cB0, voffB, 0); G_STAGE(G_SA(0, 0), cA0, voffA, 0);
  G_STAGE(G_SB(0, 1), cB1, voffB, 0); G_STAGE(G_SA(0, 1), cA1, voffA, 0);
  if (wr == 1) G_BAR;
  G_WAIT_V(4); G_BAR;
  G_STAGE(G_SB(1, 0), cB0, voffB, 1); G_STAGE(G_SA(1, 0), cA0, voffA, 1); G_STAGE(G_SB(1, 1), cB1, voffB, 1);
  G_WAIT_V(6); G_BAR;
  for (int t = 0; t < nt - 2; t += 2) {
    G_LDB(B0, 0, 0); G_SCHED; G_LDA(At, 0, 0); G_STAGE(G_SA(1, 1), cA1, voffA, t + 1);
    G_WAIT_L(8); G_BAR; G_WAIT_L(0); G_MMA(0, 0, At, B0); G_BAR; G_SCHED;
    G_LDB(B1, 0, 1); G_STAGE(G_SB(0, 0), cB0, voffB, t + 2);
    G_BAR; G_WAIT_L(0); G_MMA(0, 1, At, B1); G_BAR;
    G_LDA(At, 0, 1); G_STAGE(G_SA(0, 0), cA0, voffA, t + 2);
    G_BAR; G_WAIT_L(0); G_MMA(1, 0, At, B0); G_BAR; G_SCHED;
    G_STAGE(G_SB(0, 1), cB1, voffB, t + 2);
    G_WAIT_V(6); G_BAR; G_MMA(1, 1, At, B1); G_BAR;
    G_LDB(B0, 1, 0); G_SCHED; G_LDA(At, 1, 0); G_STAGE(G_SA(0, 1), cA1, voffA, t + 2);
    G_WAIT_L(8); G_BAR; G_WAIT_L(0); G_MMA(0, 0, At, B0); G_BAR; G_SCHED;
    G_LDB(B1, 1, 1); G_STAGE(G_SB(1, 0), cB0, voffB, t + 3);
    G_BAR; G_WAIT_L(0); G_MMA(0, 1, At, B1); G_BAR;
    G_LDA(At, 1, 1); G_STAGE(G_SA(1, 0), cA0, voffA, t + 3);
    G_BAR; G_WAIT_L(0); G_MMA(1, 0, At, B0); G_BAR; G_SCHED;
    G_STAGE(G_SB(1, 1), cB1, voffB, t + 3);
    G_WAIT_V(6); G_BAR; G_MMA(1, 1, At, B1); G_BAR;
  }
  { G_LDB(B0, 0, 0); G_LDA(At, 0, 0); G_STAGE(G_SA(1, 1), cA1, voffA, nt - 1);
    G_BAR; G_WAIT_L(0); G_MMA(0, 0, At, B0); G_BAR;
    G_LDB(B1, 0, 1); G_BAR; G_WAIT_L(0); G_MMA(0, 1, At, B1); G_BAR;
    G_LDA(At, 0, 1); G_WAIT_V(4); G_BAR; G_WAIT_L(0); G_MMA(1, 0, At, B0); G_MMA(1, 1, At, B1); G_BAR; }
  { G_LDB(B0, 1, 0); G_LDA(At, 1, 0); G_WAIT_V(2); G_BAR; G_WAIT_L(0); G_MMA(0, 0, At, B0); G_BAR;
    G_LDB(B1, 1, 1); G_WAIT_V(0); G_BAR; G_WAIT_L(0); G_MMA(0, 1, At, B1); G_BAR;
    G_LDA(At, 1, 1); G_BAR; G_WAIT_L(0); G_MMA(1, 0, At, B0); G_MMA(1, 1, At, B1); G_BAR; }
  if (wr == 0) G_BAR;
  asm volatile("" ::: "memory");
  G_SCHED;
}

struct GStream { unsigned voff[2]; };
DI void stage_offsets(const int tid, const int ld, unsigned (&voff)[2]) {
#pragma unroll
  for (int i = 0; i < 2; ++i) { int R, C; stage_rc(tid * 16 + i * 8192, R, C); voff[i] = (unsigned)(R * ld + C) * 2u; }
}
#define GS_STAGE(bufoff, gptr, vo) do { _Pragma("unroll") for (int _i = 0; _i < 2; ++_i) \
    __builtin_amdgcn_global_load_lds((const unsigned*)((gptr) + (vo)[_i]), (LAS unsigned*)(lds + (bufoff) + ldsw + _i * 8192), 16, 0, 0); } while (0)
DI void gemm_begin(const int tid, const bf16_t* A, const bf16_t* Bm, const int ld, LAS char* lds) {
  const int wid = __builtin_amdgcn_readfirstlane(tid >> 6), wr = wid >> 2;
  unsigned vo[2]; stage_offsets(tid, ld, vo);
  const unsigned ldsw = (unsigned)wid * 1024u;
  const char* cA = (const char*)A; const char* cB = (const char*)Bm;
  const size_t hstep = (size_t)HALF * ld * 2, kstep = BK * 2;
  __syncthreads();
  GS_STAGE(G_SB(0, 0), cB, vo); GS_STAGE(G_SB(0, 1), cB + hstep, vo); GS_STAGE(G_SA(0, 0), cA, vo); GS_STAGE(G_SA(0, 1), cA + hstep, vo);
  if (wr == 1) G_BAR;
  G_WAIT_V(2); G_BAR;
  GS_STAGE(G_SB(1, 0), cB + kstep, vo); GS_STAGE(G_SA(1, 0), cA + kstep, vo); GS_STAGE(G_SB(1, 1), cB + hstep + kstep, vo);
  G_WAIT_V(6); G_BAR;
}
DI void gemm_end(const int tid) {
  const int wr = __builtin_amdgcn_readfirstlane(tid >> 6) >> 2;
  G_WAIT_V(0);
  if (wr == 0) G_BAR;
  G_BAR;
}
DI void gemm_unit(const int tid, const bf16_t* A, const bf16_t* Bm, const int ld, const int K,
                  const bf16_t* An, const bf16_t* Bn, const int ldn, LAS char* lds, f32x4 (&acc)[2][2][4][2]) {
  const int wid = __builtin_amdgcn_readfirstlane(tid >> 6), lane = tid & 63, wr = wid >> 2, wc = wid & 3, fr = lane & 15, fq = lane >> 4;
  unsigned voC[2], voN[2]; stage_offsets(tid, ld, voC); stage_offsets(tid, ldn, voN);
  const unsigned ldsw = (unsigned)wid * 1024u;
  const int aoff = lds_byte(wr * 64 + fr, fq * 8), boff = lds_byte(wc * 32 + fr, fq * 8);
  const char* cA = (const char*)A; const char* cB = (const char*)Bm;
  const char* nA = (const char*)An; const char* nB = (const char*)Bn;
  const size_t hstepC = (size_t)HALF * ld * 2, hstepN = (size_t)HALF * ldn * 2, kstep = BK * 2;
#pragma unroll
  for (int a = 0; a < 2; ++a)
#pragma unroll
    for (int b = 0; b < 2; ++b)
#pragma unroll
      for (int m = 0; m < 4; ++m)
#pragma unroll
        for (int n = 0; n < 2; ++n) acc[a][b][m][n] = (f32x4){0.f, 0.f, 0.f, 0.f};
  bf16x8 At[4][2], B0[2][2], B1[2][2];
  const int nt = K / BK;
  for (int t = 0; t < nt; t += 2) {
    const bool last = (t == nt - 2);
    const char* a1 = cA + (size_t)(t + 1) * kstep;
    const char* a2 = last ? nA : cA + (size_t)(t + 2) * kstep; const char* b2 = last ? nB : cB + (size_t)(t + 2) * kstep;
    const char* a3 = a2 + kstep; const char* b3 = b2 + kstep;
    const size_t hs2 = last ? hstepN : hstepC;
    unsigned vo2[2]; vo2[0] = last ? voN[0] : voC[0]; vo2[1] = last ? voN[1] : voC[1];
    G_LDB(B0, 0, 0); G_LDB(B1, 0, 1); G_SCHED; G_LDA(At, 0, 0); GS_STAGE(G_SA(1, 1), a1 + hstepC, voC);
    G_WAIT_V(8); G_WAIT_L(0); G_BAR; G_MMA(0, 0, At, B0); G_MMA(0, 1, At, B1); G_BAR; G_SCHED;
    G_LDA(At, 0, 1); GS_STAGE(G_SB(0, 0), b2, vo2); GS_STAGE(G_SB(0, 1), b2 + hs2, vo2); GS_STAGE(G_SA(0, 0), a2, vo2);
    G_WAIT_V(8); G_WAIT_L(0); G_BAR; G_MMA(1, 0, At, B0); G_MMA(1, 1, At, B1); G_BAR; G_SCHED;
    G_LDB(B0, 1, 0); G_LDB(B1, 1, 1); G_SCHED; G_LDA(At, 1, 0); GS_STAGE(G_SA(0, 1), a2 + hs2, vo2);
    G_WAIT_V(8); G_WAIT_L(0); G_BAR; G_MMA(0, 0, At, B0); G_MMA(0, 1, At, B1); G_BAR; G_SCHED;
    G_LDA(At, 1, 1); GS_STAGE(G_SB(1, 0), b3, vo2); GS_STAGE(G_SB(1, 1), b3 + hs2, vo2); GS_STAGE(G_SA(1, 0), a3, vo2);
    G_WAIT_V(8); G_WAIT_L(0); G_BAR; G_MMA(1, 0, At, B0); G_MMA(1, 1, At, B1); G_BAR; G_SCHED;
  }
  asm volatile("" ::: "memory");
  G_SCHED;
}

struct Geo { int wr, wc, fr, fq; };
DI Geo geo(const int tid) { const int wid = tid >> 6, lane = tid & 63; Geo g; g.wr = wid >> 2; g.wc = wid & 3; g.fr = lane & 15; g.fq = lane >> 4; return g; }
DI void st4(bf16_t* p, f32x4 v) { u32x2 o; o.x = pk2(v[0], v[1]); o.y = pk2(v[2], v[3]); *(u32x2*)p = o; }

enum { EP_PLAIN = 0, EP_SILU = 1, EP_ROPE = 2, EP_KFRAG = 4 };
DI u32x4 widen_pair(const u32x2 a, const u32x2 b) {
  const auto r0 = __builtin_amdgcn_permlane16_swap(a.x, b.x, false, false);
  const auto r1 = __builtin_amdgcn_permlane16_swap(a.y, b.y, false, false);
  u32x4 o; o.x = r0[0]; o.y = r1[0]; o.z = r0[1]; o.w = r1[1]; return o;
}
DI void unwiden_pair(const u32x4 w, u32x2& a, u32x2& b) {
  const auto r0 = __builtin_amdgcn_permlane16_swap(w.x, w.z, false, false);
  const auto r1 = __builtin_amdgcn_permlane16_swap(w.y, w.w, false, false);
  a.x = r0[0]; a.y = r1[0]; b.x = r0[1]; b.y = r1[1];
}
DI u32x4 widen32_pair(const u32x2 a, const u32x2 b) {
  const auto r0 = __builtin_amdgcn_permlane32_swap(a.x, b.x, false, false);
  const auto r1 = __builtin_amdgcn_permlane32_swap(a.y, b.y, false, false);
  u32x4 o; o.x = r0[0]; o.y = r1[0]; o.z = r0[1]; o.w = r1[1]; return o;
}
DI void unwiden32_pair(const u32x4 w, u32x2& a, u32x2& b) {
  const auto r0 = __builtin_amdgcn_permlane32_swap(w.x, w.z, false, false);
  const auto r1 = __builtin_amdgcn_permlane32_swap(w.y, w.w, false, false);
  a.x = r0[0]; a.y = r1[0]; b.x = r0[1]; b.y = r1[1];
}
DI u32x2 pk4(const f32x4 v) { u32x2 o; o.x = pk2(v[0], v[1]); o.y = pk2(v[2], v[3]); return o; }
DI void epi_rowmajor(const int tid, f32x4 (&acc)[2][2][4][2], bf16_t* dst, int ld, int tok0, int col0, int mode, const f32x2* rope) {
  const Geo g = geo(launder(tid));
  const int tokb = launder(tok0 + g.wc * 32 + g.fr);
  const int base = tokb * ld + col0 + g.wr * 64 + g.fq * 4;
#pragma unroll
  for (int ai = 0; ai < 2; ++ai)
#pragma unroll
    for (int bj = 0; bj < 2; ++bj)
#pragma unroll
      for (int n = 0; n < 2; ++n) {
        bf16_t* drow = dst + (base + (bj * 128 + n * 16) * ld + ai * 128);
        if ((mode & EP_ROPE) && g.wr == 0) {
          const int tok = tokb + bj * 128 + n * 16;
          const f32x2* cs = rope + (tok & (SEQ - 1)) * 16 + g.fq * 4;
          const f32x4 x1 = acc[ai][bj][0][n], x2 = acc[ai][bj][1][n];
#pragma unroll
          for (int j = 0; j < 4; ++j) { const f32x2 c = cs[j]; acc[ai][bj][0][n][j] = x1[j] * c.x - x2[j] * c.y; acc[ai][bj][1][n][j] = x2[j] * c.x + x1[j] * c.y; }
        }
        if (mode & EP_KFRAG) {
          const int tok = tokb + bj * 128 + n * 16, key = tok & (ld * 32 - 1);
          const int head = (col0 >> 7) + ai;
          bf16_t* kp = dst + ((size_t)((head * ld + (key >> 5)) * 8 + g.wr * 4) * 2 + (g.fq >> 1)) * 256 + (key & 31) * 8 + (g.fq & 1) * 512;
#pragma unroll
          for (int m = 0; m < 4; m += 2) *(u32x4*)(kp + m * 512) = widen_pair(pk4(acc[ai][bj][m][n]), pk4(acc[ai][bj][m + 1][n]));
        } else {
          bf16_t* drow2 = drow + ((g.fq & 1) ? 12 : 0);
#pragma unroll
          for (int m = 0; m < 4; m += 2) {
            f32x4 v = acc[ai][bj][m][n], u = acc[ai][bj][m + 1][n];
            if (mode & EP_SILU) {
              v[0] = silu_f(v[0]); v[1] = silu_f(v[1]); v[2] = silu_f(v[2]); v[3] = silu_f(v[3]);
              u[0] = silu_f(u[0]); u[1] = silu_f(u[1]); u[2] = silu_f(u[2]); u[3] = silu_f(u[3]);
            }
            *(u32x4*)(drow2 + m * 16) = widen_pair(pk4(v), pk4(u));
          }
        }
        __builtin_amdgcn_sched_barrier(0);
      }
}
DI void epi_vfrag(const int tid, f32x4 (&acc)[2][2][4][2], bf16_t* dstF, int ntile, int s0, int head0) {
  const Geo g = geo(launder(tid));
  const int lanepart = launder(((g.fq & 1) * 32 + g.fr) * 8);
#pragma unroll
  for (int ai = 0; ai < 2; ++ai)
#pragma unroll
    for (int bj = 0; bj < 2; ++bj)
#pragma unroll
      for (int m = 0; m < 4; m += 2)
#pragma unroll
        for (int n = 0; n < 2; ++n) {
          const int ms = m + (g.fq >> 1);
          const int kt = (s0 >> 5) + ai * 4 + g.wr * 2 + (ms >> 1);
          const size_t idx = ((size_t)(((head0 + bj) * ntile + kt) * 4 + g.wc) * 2 + (ms & 1)) * 512 + n * 128 + lanepart;
          *(u32x4*)(dstF + idx) = widen32_pair(pk4(acc[ai][bj][m][n]), pk4(acc[ai][bj][m + 1][n]));
        }
}
DI void epi_transposed(const int tid, f32x4 (&acc)[2][2][4][2], bf16_t* dstT, int slen, int s0, int feat0) {
  const Geo g = geo(launder(tid));
  const int featb = launder(feat0 + g.wc * 32 + g.fr);
  const int base = featb * slen + s0 + g.wr * 64 + (g.fq & 1) * 8 + (g.fq >> 1) * 16;
#pragma unroll
  for (int ai = 0; ai < 2; ++ai)
#pragma unroll
    for (int bj = 0; bj < 2; ++bj)
#pragma unroll
      for (int m = 0; m < 4; m += 2)
#pragma unroll
        for (int n = 0; n < 2; ++n)
          *(u32x4*)(dstT + (base + (bj * 128 + n * 16) * slen + ai * 128 + m * 16)) = widen32_pair(pk4(acc[ai][bj][m][n]), pk4(acc[ai][bj][m + 1][n]));
}
DI void epi_gate(const int tid, f32x4 (&acc)[2][2][4][2], const bf16_t* T, bf16_t* Y, int tok0, int col0, bool first) {
  const Geo g = geo(launder(tid));
  const int tokb = launder(tok0 + g.wc * 32 + g.fr);
  const int base = tokb * DM + col0 + g.wr * 64 + g.fq * 4 + ((g.fq & 1) ? 12 : 0);
#pragma unroll
  for (int ai = 0; ai < 2; ++ai)
#pragma unroll
    for (int bj = 0; bj < 2; ++bj)
#pragma unroll
      for (int n = 0; n < 2; ++n)
#pragma unroll
        for (int m = 0; m < 4; m += 2) {
          const int off = base + (bj * 128 + n * 16) * DM + ai * 128 + m * 16;
          u32x2 ta, tb; unwiden_pair(*(const u32x4*)(T + off), ta, tb);
          const f32x4 a = acc[ai][bj][m][n], b = acc[ai][bj][m + 1][n];
          f32x4 ya, yb;
          ya[0] = sigmoid_f(a[0]) * bf_lo(ta.x); ya[1] = sigmoid_f(a[1]) * bf_hi(ta.x); ya[2] = sigmoid_f(a[2]) * bf_lo(ta.y); ya[3] = sigmoid_f(a[3]) * bf_hi(ta.y);
          yb[0] = sigmoid_f(b[0]) * bf_lo(tb.x); yb[1] = sigmoid_f(b[1]) * bf_hi(tb.x); yb[2] = sigmoid_f(b[2]) * bf_lo(tb.y); yb[3] = sigmoid_f(b[3]) * bf_hi(tb.y);
          if (!first) {
            u32x2 oa, ob; unwiden_pair(*(const u32x4*)(Y + off), oa, ob);
            ya[0] += bf_lo(oa.x); ya[1] += bf_hi(oa.x); ya[2] += bf_lo(oa.y); ya[3] += bf_hi(oa.y);
            yb[0] += bf_lo(ob.x); yb[1] += bf_hi(ob.x); yb[2] += bf_lo(ob.y); yb[3] += bf_hi(ob.y);
          }
          *(u32x4*)(Y + off) = widen_pair(pk4(ya), pk4(yb));
        }
}
DI void epi_out(const int tid, f32x4 (&acc)[2][2][4][2], const float* x, float* out, float* rowss, int tok0, int col0) {
  const Geo g = geo(launder(tid));
  const int tokb = launder(tok0 + g.wc * 32 + g.fr);
  const int base = tokb * DM + col0 + g.wr * 64 + g.fq * 4;
#pragma unroll
  for (int bj = 0; bj < 2; ++bj)
#pragma unroll
    for (int n = 0; n < 2; ++n) {
      float ss = 0.f;
#pragma unroll
      for (int ai = 0; ai < 2; ++ai)
#pragma unroll
        for (int m = 0; m < 4; ++m) {
          const int off = base + (bj * 128 + n * 16) * DM + ai * 128 + m * 16;
          const f32x4 xv = *(const f32x4*)(x + off);
          const f32x4 z = xv + acc[ai][bj][m][n];
          *(f32x4*)(out + off) = z;
          ss += z[0] * z[0] + z[1] * z[1] + z[2] * z[2] + z[3] * z[3];
        }
      ss += __shfl_xor(ss, 16); ss += __shfl_xor(ss, 32);
      if (g.fq == 0) atomicAdd(rowss + (tokb + bj * 128 + n * 16), ss);
    }
}

DI void epi_out_norm(const int tid, f32x4 (&acc)[2][2][4][2], const float* x, float* out, float* rowss, unsigned* cnt, const float* gfin,
                     int tok0, int col0, LAS unsigned* lcnt) {
  const Geo g = geo(launder(tid));
  const int lane = tid & 63;
  const int tokb = launder(tok0 + g.wc * 32 + g.fr);
  const int base = tokb * DM + col0 + g.wr * 64 + g.fq * 4;
#pragma unroll
  for (int bj = 0; bj < 2; ++bj)
#pragma unroll
    for (int n = 0; n < 2; ++n) {
      float ss = 0.f;
#pragma unroll
      for (int ai = 0; ai < 2; ++ai)
#pragma unroll
        for (int m = 0; m < 4; ++m) {
          const int off = base + (bj * 128 + n * 16) * DM + ai * 128 + m * 16;
          const f32x4 xv = *(const f32x4*)(x + off);
          const f32x4 z = xv + acc[ai][bj][m][n];
          acc[ai][bj][m][n] = z;
          ss += z[0] * z[0] + z[1] * z[1] + z[2] * z[2] + z[3] * z[3];
        }
      ss += __shfl_xor(ss, 16); ss += __shfl_xor(ss, 32);
      if (g.fq == 0) __hip_atomic_fetch_add(rowss + (tokb + bj * 128 + n * 16), ss, __ATOMIC_RELAXED, __HIP_MEMORY_SCOPE_AGENT);
    }
  asm volatile("s_waitcnt vmcnt(0)" ::: "memory");
  if (lane == 0) {
    const unsigned old = __hip_atomic_fetch_add((unsigned*)lcnt, 1u, __ATOMIC_RELAXED, __HIP_MEMORY_SCOPE_WORKGROUP);
    if (old == 7u) {
      __hip_atomic_store((unsigned*)lcnt, 0u, __ATOMIC_RELAXED, __HIP_MEMORY_SCOPE_WORKGROUP);
      __builtin_amdgcn_fence(__ATOMIC_RELEASE, "agent");
      __hip_atomic_fetch_add(cnt, 1u, __ATOMIC_RELAXED, __HIP_MEMORY_SCOPE_AGENT);
    }
  }
  while (__hip_atomic_load(cnt, __ATOMIC_RELAXED, __HIP_MEMORY_SCOPE_AGENT) < 4u) __builtin_amdgcn_s_sleep(1);
  __builtin_amdgcn_fence(__ATOMIC_ACQUIRE, "agent");
  f32x4 gfv[2][4];
#pragma unroll
  for (int ai = 0; ai < 2; ++ai)
#pragma unroll
    for (int m = 0; m < 4; ++m) gfv[ai][m] = *(const f32x4*)(gfin + col0 + g.wr * 64 + g.fq * 4 + ai * 128 + m * 16);
#pragma unroll
  for (int bj = 0; bj < 2; ++bj)
#pragma unroll
    for (int n = 0; n < 2; ++n) {
      const float tot = __hip_atomic_load(rowss + (tokb + bj * 128 + n * 16), __ATOMIC_RELAXED, __HIP_MEMORY_SCOPE_AGENT);
      const float rs = rsqrtf(tot * (1.f / DM) + 1e-6f);
#pragma unroll
      for (int ai = 0; ai < 2; ++ai)
#pragma unroll
        for (int m = 0; m < 4; ++m) {
          const int off = base + (bj * 128 + n * 16) * DM + ai * 128 + m * 16;
          const f32x4 gg = gfv[ai][m];
          const f32x4 z = acc[ai][bj][m][n];
          f32x4 o; o[0] = z[0] * rs * gg[0]; o[1] = z[1] * rs * gg[1]; o[2] = z[2] * rs * gg[2]; o[3] = z[3] * rs * gg[3];
          *(f32x4*)(out + off) = o;
        }
    }
}

DI void p0_transpose_item(const float* W, int K, int N, bf16_t* WT, LAS float* scr, int item, int lane) {
  const int nblk = N / 32, kb = item / nblk, nb = item % nblk, k0 = 64 * kb, n0 = 32 * nb;
#pragma unroll 8
  for (int i = 0; i < 32; ++i) { const int kk = 2 * i + (lane >> 5); scr[kk * 33 + (lane & 31)] = W[(size_t)(k0 + kk) * N + n0 + (lane & 31)]; }
  lds_wait();
  const int c = lane & 7;
#pragma unroll
  for (int j = 0; j < 4; ++j) {
    const int n = (lane >> 3) + 8 * j; const LAS float* s = scr + (8 * c) * 33 + n;
    u32x4 o; o.x = pk2(s[0 * 33], s[1 * 33]); o.y = pk2(s[2 * 33], s[3 * 33]); o.z = pk2(s[4 * 33], s[5 * 33]); o.w = pk2(s[6 * 33], s[7 * 33]);
    *(u32x4*)(WT + (size_t)(n0 + n) * K + k0 + 8 * c) = o;
  }
  lds_wait();
}
DI void rms_row_bf16(const float* xr, const float* gw, bf16_t* orow, int lane) {
  f32x4 v[4]; float s = 0.f;
#pragma unroll
  for (int j = 0; j < 4; ++j) { v[j] = ((const f32x4*)xr)[lane + 64 * j]; s += v[j][0] * v[j][0] + v[j][1] * v[j][1] + v[j][2] * v[j][2] + v[j][3] * v[j][3]; }
  s = wave_sum(s);
  const float rs = rsqrtf(s * (1.f / DM) + 1e-6f);
#pragma unroll
  for (int j = 0; j < 4; ++j) {
    const f32x4 gg = ((const f32x4*)gw)[lane + 64 * j];
    u32x2 o; o.x = pk2(v[j][0] * rs * gg[0], v[j][1] * rs * gg[1]); o.y = pk2(v[j][2] * rs * gg[2], v[j][3] * rs * gg[3]);
    *(u32x2*)(orow + 4 * (lane + 64 * j)) = o;
  }
}
DI void phase0(const Params& p, LAS char* lds, const int wv) {
  const int tid = make_tid(wv), wave = tid >> 6, lane = tid & 63, G = gridDim.x;
  const int gw = blockIdx.x * 8 + wave, NGW = G * 8;
  const size_t gt = (size_t)blockIdx.x * NTHREADS + tid, NGT = (size_t)G * NTHREADS;
  char* ws = p.ws;
  if (gt < 144) ((unsigned*)(ws + OFF_BAR))[gt] = 0u;
  if (gt < 24 * 32) ((unsigned*)(ws + OFF_GCNT))[gt] = 0u;
  if (gt < 128) ((unsigned*)(ws + OFF_C5))[gt] = 0u;
  for (size_t i = gt; i < MTOK; i += NGT) ((float*)(ws + OFF_ROWSS))[i] = 0.f;
  for (size_t i = gt; i < (size_t)SEQ * 16; i += NGT) {
    const int pos = (int)(i >> 4), f = (int)(i & 15);
    const float inv = powf(500000.0f, -(float)f * (1.f / 16.f));
    const float ang = (float)pos * inv;
    f32x2 cs; cs.x = cosf(ang); cs.y = sinf(ang);
    ((f32x2*)(ws + OFF_ROPE))[i] = cs;
  }
  f32x4 gx[4];
#pragma unroll
  for (int j = 0; j < 2; ++j) { gx[2 * j] = ((const f32x4*)p.norm_g)[2 * (lane + 64 * j)]; gx[2 * j + 1] = ((const f32x4*)p.norm_g)[2 * (lane + 64 * j) + 1]; }
  for (int r0 = gw; r0 < MTOK + NB * 256; r0 += 4 * NGW) {
    f32x4 v[4][4]; float ss[4]; bf16_t* osel[4]; bool ok[4], ismem[4];
#pragma unroll
    for (int k = 0; k < 4; ++k) {
      const int r = r0 + k * NGW;
      ok[k] = r < MTOK + NB * 256;
      const int rc = ok[k] ? r : r0;
      const float* xr;
      ismem[k] = rc >= MTOK;
      if (!ismem[k]) { xr = p.x + (size_t)rc * DM; osel[k] = (bf16_t*)(ws + OFF_HB) + (size_t)rc * DM; }
      else { const int m = rc - MTOK; xr = p.mem + (size_t)m * DM; osel[k] = (bf16_t*)(ws + OFF_MEMN) + (size_t)m * DM; }
#pragma unroll
      for (int j = 0; j < 2; ++j) { v[k][2 * j] = ((const f32x4*)xr)[2 * (lane + 64 * j)]; v[k][2 * j + 1] = ((const f32x4*)xr)[2 * (lane + 64 * j) + 1]; }
    }
#pragma unroll
    for (int k = 0; k < 4; ++k) {
      float s_ = 0.f;
#pragma unroll
      for (int j = 0; j < 4; ++j) s_ += v[k][j][0] * v[k][j][0] + v[k][j][1] * v[k][j][1] + v[k][j][2] * v[k][j][2] + v[k][j][3] * v[k][j][3];
      ss[k] = s_;
    }
#pragma unroll
    for (int o = 1; o < 64; o <<= 1) {
#pragma unroll
      for (int k = 0; k < 4; ++k) ss[k] += __shfl_xor(ss[k], o);
    }
#pragma unroll
    for (int k = 0; k < 4; ++k) {
      if (ok[k]) {
        const float rs = rsqrtf(ss[k] * (1.f / DM) + 1e-6f);
#pragma unroll
        for (int j = 0; j < 2; ++j) {
          f32x4 g0 = gx[2 * j], g1 = gx[2 * j + 1];
          if (ismem[k]) { g0 = ((const f32x4*)p.mem_norm_g)[2 * (lane + 64 * j)]; g1 = ((const f32x4*)p.mem_norm_g)[2 * (lane + 64 * j) + 1]; }
          const f32x4 a = v[k][2 * j], c = v[k][2 * j + 1];
          u32x4 o; o.x = pk2(a[0] * rs * g0[0], a[1] * rs * g0[1]); o.y = pk2(a[2] * rs * g0[2], a[3] * rs * g0[3]);
          o.z = pk2(c[0] * rs * g1[0], c[1] * rs * g1[1]); o.w = pk2(c[2] * rs * g1[2], c[3] * rs * g1[3]);
          *(u32x4*)(osel[k] + 8 * (lane + 64 * j)) = o;
        }
      }
    }
  }
  LAS float* scr = (LAS float*)(lds + wave * 8448);
  constexpr int I_IN = 16 * (INW / 32), I_MKV = 16 * 32, I_A = 12 * 32, I_C = 8 * 32, I_O = 16 * 32;
  constexpr int NITEMS = I_IN + I_MKV + 2 * I_A + I_C + I_O;
  for (int it = gw; it < NITEMS; it += NGW) {
    int r = it;
    if (r < I_IN) { p0_transpose_item(p.w_in, 1024, INW, (bf16_t*)(ws + OFF_WIN), scr, r, lane); continue; } r -= I_IN;
    if (r < I_MKV) { p0_transpose_item(p.w_mkv, 1024, 1024, (bf16_t*)(ws + OFF_WMKV), scr, r, lane); continue; } r -= I_MKV;
    if (r < I_A) { p0_transpose_item(p.w_a, 768, 1024, (bf16_t*)(ws + OFF_WA), scr, r, lane); continue; } r -= I_A;
    if (r < I_A) { p0_transpose_item(p.w_b, 768, 1024, (bf16_t*)(ws + OFF_WB), scr, r, lane); continue; } r -= I_A;
    if (r < I_C) { p0_transpose_item(p.w_c, 512, 1024, (bf16_t*)(ws + OFF_WC), scr, r, lane); continue; } r -= I_C;
    p0_transpose_item(p.w_out, 1024, 1024, (bf16_t*)(ws + OFF_WO), scr, r, lane);
  }
}

struct P1Ops { const bf16_t *A, *B; int tt, ct; bool memkv, tr; };
DI P1Ops p1_ops(char* ws, int L, bool swz, int xcd) {
  P1Ops o;
  if (swz) {
    if (L < 400) { const int grp = L / 200, r = L % 200; o.tt = xcd * 16 + grp * 8 + (r & 7); o.ct = r >> 3; o.memkv = false; }
    else { o.memkv = true; const int t = xcd * 2 + (L - 400); o.tt = t >> 2; o.ct = t & 3; }
  } else {
    if (L < 3200) { o.tt = L / 25; o.ct = L % 25; o.memkv = false; } else { o.memkv = true; o.tt = (L - 3200) >> 2; o.ct = (L - 3200) & 3; }
  }
  const bf16_t *Wt, *Xt;
  if (!o.memkv) {
    Wt = (const bf16_t*)(ws + OFF_WIN) + (size_t)o.ct * 256 * DM; Xt = (const bf16_t*)(ws + OFF_HB) + (size_t)o.tt * 256 * DM;
    o.tr = (o.ct >= 6 && o.ct < 9) || (o.ct >= 15 && o.ct < 18);
  } else {
    Wt = (const bf16_t*)(ws + OFF_WMKV) + (size_t)o.ct * 256 * DM; Xt = (const bf16_t*)(ws + OFF_MEMN) + (size_t)o.tt * 256 * DM;
    o.tr = o.ct >= 2;
  }
  o.A = o.tr ? Xt : Wt; o.B = o.tr ? Wt : Xt;
  return o;
}
DI void phase1(const Params& p, LAS char* lds, const int wv) {
  char* ws = p.ws;
  const int tid = make_tid(wv);
  const int G = gridDim.x, b = blockIdx.x;
  const f32x2* rope = (const f32x2*)(ws + OFF_ROPE);
  const bool swz = (G % 8) == 0;
  const int per = swz ? G / 8 : G, xcd = swz ? (b & 7) : 0, slot = swz ? (b >> 3) : b;
  const int LMAX = swz ? 402 : 3216;
  if (slot >= LMAX) return;
  { const P1Ops o = p1_ops(ws, slot, swz, xcd); gemm_begin(tid, o.A, o.B, DM, lds); }
  for (int L = slot; L < LMAX; L += per) {
    const P1Ops o = p1_ops(ws, L, swz, xcd);
    const P1Ops nx = p1_ops(ws, (L + per < LMAX) ? L + per : L, swz, xcd);
    const int tt = o.tt, ct = o.ct; const bool tr = o.tr;
    bf16_t* dst; int dld, dcol, mode, slen, s0, tok0;
    if (!o.memkv) {
      tok0 = tt * 256; slen = SEQ; s0 = (tt & 31) * 256;
      const int bb = tt >> 5;
      if (ct < 3) { dst = (bf16_t*)(ws + OFF_Q); dld = AW; dcol = ct * 256; mode = EP_ROPE; }
      else if (ct < 6) { dst = (bf16_t*)(ws + OFF_K) + (size_t)bb * 6 * 256 * 4096; dld = 256; dcol = (ct - 3) * 256; mode = EP_ROPE | EP_KFRAG; }
      else if (ct < 9) { dst = (bf16_t*)(ws + OFF_VT) + (size_t)bb * 6 * 256 * 4096; dld = 1; dcol = (ct - 6) * 2; mode = EP_PLAIN; }
      else if (ct < 12) { dst = (bf16_t*)(ws + OFF_GA); dld = AW; dcol = (ct - 9) * 256; mode = EP_SILU; }
      else if (ct < 15) { dst = (bf16_t*)(ws + OFF_UB); dld = AW; dcol = (ct - 12) * 256; mode = EP_PLAIN; }
      else if (ct < 18) { dst = (bf16_t*)(ws + OFF_VBT) + (size_t)bb * AW * SEQ; dld = 0; dcol = (ct - 15) * 256; mode = EP_PLAIN; }
      else if (ct < 21) { dst = (bf16_t*)(ws + OFF_GB); dld = AW; dcol = (ct - 18) * 256; mode = EP_SILU; }
      else if (ct < 23) { dst = (bf16_t*)(ws + OFF_QC); dld = CW; dcol = (ct - 21) * 256; mode = EP_PLAIN; }
      else { dst = (bf16_t*)(ws + OFF_GC); dld = CW; dcol = (ct - 23) * 256; mode = EP_SILU; }
    } else {
      tok0 = tt * 256; slen = 256; s0 = 0; mode = EP_PLAIN;
      if (!tr) { dst = (bf16_t*)(ws + OFF_MEMK) + (size_t)tt * 4 * 8 * 4096; dld = 8; dcol = ct * 256; mode = EP_KFRAG; }
      else { dst = (bf16_t*)(ws + OFF_MEMVT) + (size_t)tt * 4 * 8 * 4096; dld = 1; dcol = (ct - 2) * 2; }
    }
    f32x4 acc[2][2][4][2];
    gemm_unit(tid, o.A, o.B, DM, DM, nx.A, nx.B, DM, lds, acc);
    if (!tr) epi_rowmajor(tid, acc, dst, dld, tok0, dcol, mode, rope);
    else if (dld == 1) epi_vfrag(tid, acc, dst, slen >> 5, s0, dcol);
    else epi_transposed(tid, acc, dst, slen, s0, dcol);
  }
  gemm_end(tid);
}

DI void kstat_item(const int tid, const bf16_t* blk, bf16_t* kmh, const int blkidx, float* max2_out, LAS char* lds) {
  const int ks = tid >> 6, lane = tid & 63;
  LAS float* n2p = (LAS float*)lds;
  LAS float* redm = n2p + 4096;
  __syncthreads();
  float cs[8];
#pragma unroll
  for (int e = 0; e < 8; ++e) cs[e] = 0.f;
#pragma unroll
  for (int kt = 0; kt < 8; ++kt) {
    const u32x4 v = *(const u32x4*)(blk + (size_t)((kt * 8 + ks) * 64 + lane) * 8);
    const float f[8] = {bf_lo(v.x), bf_hi(v.x), bf_lo(v.y), bf_hi(v.y), bf_lo(v.z), bf_hi(v.z), bf_lo(v.w), bf_hi(v.w)};
    float n2 = 0.f;
#pragma unroll
    for (int e = 0; e < 8; ++e) { cs[e] += f[e]; n2 += f[e] * f[e]; }
    n2p[(ks * 2 + (lane >> 5)) * 256 + kt * 32 + (lane & 31)] = n2;
  }
#pragma unroll
  for (int e = 0; e < 8; ++e) {
    float c = cs[e];
    c += __shfl_xor(c, 1); c += __shfl_xor(c, 2); c += __shfl_xor(c, 4); c += __shfl_xor(c, 8); c += __shfl_xor(c, 16);
    cs[e] = c * (1.f / 256.f);
  }
  if (kmh && (lane & 31) == 0) {
    u32x4 hi, lo;
    hi.x = pk2(cs[0], cs[1]); hi.y = pk2(cs[2], cs[3]); hi.z = pk2(cs[4], cs[5]); hi.w = pk2(cs[6], cs[7]);
    lo.x = pk2(cs[0] - bf_lo(hi.x), cs[1] - bf_hi(hi.x)); lo.y = pk2(cs[2] - bf_lo(hi.y), cs[3] - bf_hi(hi.y));
    lo.z = pk2(cs[4] - bf_lo(hi.z), cs[5] - bf_hi(hi.z)); lo.w = pk2(cs[6] - bf_lo(hi.w), cs[7] - bf_hi(hi.w));
    bf16_t* d = kmh + ((size_t)(ks * 64 + (lane >> 5) * 32 + blkidx)) * 8;
    *(u32x4*)d = hi; *(u32x4*)(d + 98304) = lo;
  }
  __syncthreads();
  if (tid < 256) {
    float n = 0.f;
#pragma unroll
    for (int k = 0; k < 16; ++k) n += n2p[k * 256 + tid];
    n = wave_max(n);
    if ((tid & 63) == 0) redm[tid >> 6] = n;
  }
  __syncthreads();
  if (tid == 0) *max2_out = fmaxf(fmaxf(redm[0], redm[1]), fmaxf(redm[2], redm[3]));
  __syncthreads();
}

DI u32x4 pack_w(const f32x4 wa, const f32x4 wb) { u32x4 o; o.x = pk2(wa[0], wa[1]); o.y = pk2(wa[2], wa[3]); o.z = pk2(wb[0], wb[1]); o.w = pk2(wb[2], wb[3]); return o; }
DI u32x4 pack_w_masked(const f32x4 wa, const f32x4 wb, const int sa, const int t) {
  u32x4 o; const int sb = sa + 8;
  o.x = pk2(sa + 0 <= t ? wa[0] : 0.f, sa + 1 <= t ? wa[1] : 0.f); o.y = pk2(sa + 2 <= t ? wa[2] : 0.f, sa + 3 <= t ? wa[3] : 0.f);
  o.z = pk2(sb + 0 <= t ? wb[0] : 0.f, sb + 1 <= t ? wb[1] : 0.f); o.w = pk2(sb + 2 <= t ? wb[2] : 0.f, sb + 3 <= t ? wb[3] : 0.f);
  return o;
}
DI void gmlp_item(const int tid, const Params& p, LAS char* lds, int item) {
  char* ws = p.ws;
  const int w = tid >> 6, lane = tid & 63, r = lane & 31, hh = lane >> 5;
  const int b = item >> 6, ch = item & 63, s0 = ch * 128, tok0 = b * SEQ + s0;
  const bf16_t* VBT = (const bf16_t*)(ws + OFF_VBT) + (size_t)b * AW * SEQ + s0;
  LAS float* red = (LAS float*)lds;
  LAS float* red2 = red + 4096;
  LAS float* ra = red + 8192;
  LAS float* rb = ra + 128;
  __syncthreads();
  {
    const int oct = tid & 15, cpart = tid >> 4;
    float sum[8], sq[8];
#pragma unroll
    for (int e = 0; e < 8; ++e) { sum[e] = 0.f; sq[e] = 0.f; }
#pragma unroll 8
    for (int i = 0; i < 24; ++i) {
      const u32x4 v = *(const u32x4*)(VBT + (size_t)(cpart + 32 * i) * SEQ + oct * 8);
      const float f[8] = {bf_lo(v.x), bf_hi(v.x), bf_lo(v.y), bf_hi(v.y), bf_lo(v.z), bf_hi(v.z), bf_lo(v.w), bf_hi(v.w)};
#pragma unroll
      for (int e = 0; e < 8; ++e) { sum[e] += f[e]; sq[e] += f[e] * f[e]; }
    }
#pragma unroll
    for (int e = 0; e < 8; ++e) { red[cpart * 128 + oct * 8 + e] = sum[e]; red2[cpart * 128 + oct * 8 + e] = sq[e]; }
    __syncthreads();
    if (tid < 128) {
      float su = 0.f, s2 = 0.f;
#pragma unroll 8
      for (int k = 0; k < 32; ++k) { su += red[k * 128 + tid]; s2 += red2[k * 128 + tid]; }
      const float mu = su * (1.f / AW); const float var = fmaxf(s2 * (1.f / AW) - mu * mu, 0.f);
      const float rr = rsqrtf(var + 1e-6f);
      ra[tid] = rr; rb[tid] = mu * rr;
    }
    __syncthreads();
  }
  const int ct = w & 3, gh = w >> 2;
  const bf16_t* UB = (const bf16_t*)(ws + OFF_UB);
  bf16_t* OB = (bf16_t*)((char*)p.out + DO_OB);
  const bf16_t* GB = (const bf16_t*)(ws + OFF_GB);
#pragma unroll 1
  for (int it = 0; it < 3; ++it) {
    const int g = gh * 3 + it;
    f32x16 acc[4];
#pragma unroll
    for (int T = 0; T < 4; ++T)
#pragma unroll
      for (int i = 0; i < 16; ++i) acc[T][i] = 0.f;
    const int c = g * 128 + ct * 32 + r;
    const float lgc = p.ln_g[c];
    const float* wrow = p.w_sp + ((size_t)g * 128 + r) * 128;
#pragma unroll
    for (int ks = 0; ks < 8; ++ks) {
      const u32x4 raw = *(const u32x4*)(VBT + (size_t)c * SEQ + 16 * ks + 8 * hh);
      const f32x4 r0 = *(const LAS f32x4*)(ra + 16 * ks + 8 * hh), r1 = *(const LAS f32x4*)(ra + 16 * ks + 8 * hh + 4);
      const f32x4 m0 = *(const LAS f32x4*)(rb + 16 * ks + 8 * hh), m1 = *(const LAS f32x4*)(rb + 16 * ks + 8 * hh + 4);
      u32x4 a;
      a.x = pk2((bf_lo(raw.x) * r0[0] - m0[0]) * lgc, (bf_hi(raw.x) * r0[1] - m0[1]) * lgc);
      a.y = pk2((bf_lo(raw.y) * r0[2] - m0[2]) * lgc, (bf_hi(raw.y) * r0[3] - m0[3]) * lgc);
      a.z = pk2((bf_lo(raw.z) * r1[0] - m1[0]) * lgc, (bf_hi(raw.z) * r1[1] - m1[1]) * lgc);
      a.w = pk2((bf_lo(raw.w) * r1[2] - m1[2]) * lgc, (bf_hi(raw.w) * r1[3] - m1[3]) * lgc);
      const bf16x8 af = __builtin_bit_cast(bf16x8, a);
      const int sa = 16 * ks + 4 * hh;
#pragma unroll
      for (int T = 0; T < 4; ++T) {
        if (ks <= 2 * T + 1) {
          const float* wt = wrow + T * 32 * 128;
          const f32x4 wa = *(const f32x4*)(wt + sa), wb = *(const f32x4*)(wt + sa + 8);
          const u32x4 bb = (ks >= 2 * T) ? pack_w_masked(wa, wb, sa, T * 32 + r) : pack_w(wa, wb);
          acc[T] = mfma32(af, __builtin_bit_cast(bf16x8, bb), acc[T]);
        }
      }
      if (ks & 1) __builtin_amdgcn_sched_barrier(0);
    }
#pragma unroll
    for (int T = 0; T < 4; ++T) {
      const int t = T * 32 + r;
      const float bias = p.b_sp[g * 128 + t];
      const size_t rowoff = (size_t)(tok0 + t) * AW + g * 128 + ct * 32 + 8 * hh;
#pragma unroll
      for (int i4 = 0; i4 < 4; i4 += 2) {
        const size_t off = rowoff + 8 * i4;
        u32x2 ua, ub2, ga, gb2;
        unwiden32_pair(*(const u32x4*)(UB + off), ua, ub2);
        unwiden32_pair(*(const u32x4*)(GB + off), ga, gb2);
        f32x4 oa, ob;
#pragma unroll
        for (int e = 0; e < 4; ++e) {
          const float a0 = acc[T][4 * i4 + e], a1 = acc[T][4 * i4 + 4 + e];
          const unsigned uw0 = (e < 2) ? ua.x : ua.y, gw0 = (e < 2) ? ga.x : ga.y, uw1 = (e < 2) ? ub2.x : ub2.y, gw1 = (e < 2) ? gb2.x : gb2.y;
          const float u0 = (e & 1) ? bf_hi(uw0) : bf_lo(uw0), g0 = (e & 1) ? bf_hi(gw0) : bf_lo(gw0);
          const float u1 = (e & 1) ? bf_hi(uw1) : bf_lo(uw1), g1 = (e & 1) ? bf_hi(gw1) : bf_lo(gw1);
          oa[e] = u0 * (a0 + bias) * g0; ob[e] = u1 * (a1 + bias) * g1;
        }
        *(u32x4*)(OB + off) = widen32_pair(pk4(oa), pk4(ob));
      }
    }
  }
}

DI void phase2(const Params& p, LAS char* lds, const int wv) {
  char* ws = p.ws;
  const int tid = make_tid(wv);
  for (int it = blockIdx.x; it < 256 + 768 + 16; it += gridDim.x) {
    if (it < 256) { for (int rg = 0; rg < REP2G; ++rg) gmlp_item(tid, p, lds, it); }
    else if (it < 1024) {
      const int k = it - 256, blk = k & 31, bh = k >> 5, h = bh % 6, b = bh / 6;
      kstat_item(tid, (const bf16_t*)(ws + OFF_K) + ((size_t)bh * 256 + blk * 8) * 4096,
                 (bf16_t*)(ws + OFF_KMEAN) + (size_t)bh * 4096, blk, (float*)(ws + OFF_KMAX2) + k, lds);
    } else {
      const int k = it - 1024, hd = k & 3, b = k >> 2;
      kstat_item(tid, (const bf16_t*)(ws + OFF_MEMK) + (size_t)k * 8 * 4096, nullptr, 0, (float*)(ws + OFF_MKMAX2) + k, lds);
    }
  }
}

constexpr float ATT_SC = 0.08838834764831845f * 1.4426950408889634f;
DI bf16x8 ldfrag(const bf16_t* p) { return *(const bf16x8*)p; }
DI bf16x8 ldfrag(const LAS bf16_t* p) { return *(const LAS bf16x8*)p; }
template <class KP>
DI void attn_unit(const bf16x8 (&qf)[8], KP Kt, KP Vt, int nkt, float cs, int qpos, int hh, f32x16 (&o)[4], float& lsum) {
  bf16x8 kf[8], vf[8];
#pragma unroll
  for (int f = 0; f < 8; ++f) kf[f] = ldfrag(Kt + f * 512);
#pragma unroll
  for (int f = 0; f < 8; ++f) vf[f] = ldfrag(Vt + f * 512);
#pragma unroll 1
  for (int kt = 0; kt < nkt; ++kt) {
    f32x16 s;
#pragma unroll
    for (int i = 0; i < 16; ++i) s[i] = 0.f;
#pragma unroll
    for (int ks = 0; ks < 8; ++ks) s = mfma32(kf[ks], qf[ks], s);
    const int ktn = (kt + 1 < nkt) ? kt + 1 : kt;
#pragma unroll
    for (int f = 0; f < 8; ++f) kf[f] = ldfrag(Kt + ktn * 4096 + f * 512);
#pragma unroll
    for (int i = 0; i < 16; ++i) {
      const int key = kt * 32 + crow(i, hh);
      float pv = __builtin_amdgcn_exp2f(s[i] * ATT_SC - cs);
      pv = key > qpos ? 0.f : pv;
      lsum += pv; s[i] = pv;
    }
    u32x4 a, b;
    a.x = pk2(s[0], s[1]); a.y = pk2(s[2], s[3]); a.z = pk2(s[4], s[5]); a.w = pk2(s[6], s[7]);
    b.x = pk2(s[8], s[9]); b.y = pk2(s[10], s[11]); b.z = pk2(s[12], s[13]); b.w = pk2(s[14], s[15]);
    const bf16x8 p0 = __builtin_bit_cast(bf16x8, a), p1 = __builtin_bit_cast(bf16x8, b);
#pragma unroll
    for (int dt = 0; dt < 4; ++dt) { o[dt] = mfma32(vf[dt * 2], p0, o[dt]); o[dt] = mfma32(vf[dt * 2 + 1], p1, o[dt]); }
#pragma unroll
    for (int f = 0; f < 8; ++f) vf[f] = ldfrag(Vt + ktn * 4096 + f * 512);
  }
}
template <bool CAUSAL>
DI void attn_unit_lds(const bf16x8 (&qf)[8], const LAS bf16_t* Kt, const LAS bf16_t* Vt, const int nkt, float cs, const int qpos, const int hh, f32x16 (&o)[4], float& lsum) {
  f32x16 zero;
#pragma unroll
  for (int i = 0; i < 16; ++i) zero[i] = 0.f;
  const f32x2 sc2 = {ATT_SC, ATT_SC}, cs2 = {cs, cs};
  f32x2 l2 = {0.f, 0.f};
#pragma unroll 1
  for (int kt = 0; kt < nkt; ++kt) {
    f32x16 s = mfma32(*(const LAS bf16x8*)(Kt + kt * 4096), qf[0], zero);
#pragma unroll
    for (int ks = 1; ks < 8; ++ks) { const bf16x8 kf = *(const LAS bf16x8*)(Kt + kt * 4096 + ks * 512); s = mfma32(kf, qf[ks], s); }
    u32x4 a, b;
    unsigned pk[8];
#pragma unroll
    for (int i = 0; i < 8; ++i) {
      f32x2 t = {s[2 * i], s[2 * i + 1]};
      t = t * sc2 - cs2;
      t.x = __builtin_amdgcn_exp2f(t.x); t.y = __builtin_amdgcn_exp2f(t.y);
      if (CAUSAL) {
        if (kt * 32 + crow(2 * i, hh) > qpos) t.x = 0.f;
        if (kt * 32 + crow(2 * i + 1, hh) > qpos) t.y = 0.f;
      }
      l2 += t;
      pk[i] = pk2(t.x, t.y);
    }
    a.x = pk[0]; a.y = pk[1]; a.z = pk[2]; a.w = pk[3]; b.x = pk[4]; b.y = pk[5]; b.z = pk[6]; b.w = pk[7];
    const bf16x8 p0 = __builtin_bit_cast(bf16x8, a), p1 = __builtin_bit_cast(bf16x8, b);
#pragma unroll
    for (int dt = 0; dt < 4; ++dt) {
      const bf16x8 v0 = *(const LAS bf16x8*)(Vt + kt * 4096 + dt * 1024), v1 = *(const LAS bf16x8*)(Vt + kt * 4096 + dt * 1024 + 512);
      o[dt] = mfma32(v0, p0, o[dt]); o[dt] = mfma32(v1, p1, o[dt]);
    }
  }
  lsum += l2.x + l2.y;
}
DI float kmax_norm(const float* kmax2_bh) {
  float m = 0.f;
#pragma unroll
  for (int k = 0; k < 32; ++k) m = fmaxf(m, kmax2_bh[k]);
  return sqrtf(m);
}
DI float qf_norm2(const bf16x8 (&qf)[8]) {
  float n2 = 0.f;
#pragma unroll
  for (int ks = 0; ks < 8; ++ks) {
    const u32x4 u = __builtin_bit_cast(u32x4, qf[ks]);
    n2 += bf_lo(u.x) * bf_lo(u.x) + bf_hi(u.x) * bf_hi(u.x) + bf_lo(u.y) * bf_lo(u.y) + bf_hi(u.y) * bf_hi(u.y)
        + bf_lo(u.z) * bf_lo(u.z) + bf_hi(u.z) * bf_hi(u.z) + bf_lo(u.w) * bf_lo(u.w) + bf_hi(u.w) * bf_hi(u.w);
  }
  n2 += __shfl_xor(n2, 32);
  return n2;
}
struct T3 { float v1, v2, v3; int i1, i2, i3; };
DI bool t3_better(float v, int b, float w, int j) { return v > w || (v == w && b < j); }
DI T3 top3_insert(T3 t, float v, int blk) {
  const bool g1 = t3_better(v, blk, t.v1, t.i1), g2 = t3_better(v, blk, t.v2, t.i2), g3 = t3_better(v, blk, t.v3, t.i3);
  T3 r;
  r.v3 = g2 ? t.v2 : (g3 ? v : t.v3); r.i3 = g2 ? t.i2 : (g3 ? blk : t.i3);
  r.v2 = g1 ? t.v1 : (g2 ? v : t.v2); r.i2 = g1 ? t.i1 : (g2 ? blk : t.i2);
  r.v1 = g1 ? v : t.v1;               r.i1 = g1 ? blk : t.i1;
  return r;
}

constexpr int MB_K = 0, MB_V = 65536, MB_PRE = 131072, MB_END = MB_PRE + 768 * 4;
DI void stage_kv_block(const int tid, const bf16_t* kblk, const bf16_t* vblk, LAS char* lds) {
  const u32x4* ksrc = (const u32x4*)kblk; const u32x4* vsrc = (const u32x4*)vblk;
  u32x4 kk[8];
#pragma unroll
  for (int i = 0; i < 8; ++i) kk[i] = ksrc[tid + 512 * i];
#pragma unroll
  for (int i = 0; i < 8; ++i) *(LAS u32x4*)(lds + MB_K + (tid + 512 * i) * 16) = kk[i];
  __builtin_amdgcn_sched_barrier(0);
#pragma unroll
  for (int i = 0; i < 8; ++i) kk[i] = vsrc[tid + 512 * i];
#pragma unroll
  for (int i = 0; i < 8; ++i) *(LAS u32x4*)(lds + MB_V + (tid + 512 * i) * 16) = kk[i];
  __builtin_amdgcn_sched_barrier(0);
}
constexpr int MA_CNT = 131072, MA_BASE = MA_CNT + 128, MA_LIST = MA_CNT + 256, MA_END = MA_LIST + 32 * 256 * 2;
DI void store_partial(bf16_t* po, const f32x16 (&o)[4], const int hh) {
#pragma unroll
  for (int dt = 0; dt < 4; ++dt)
#pragma unroll
    for (int i4 = 0; i4 < 4; i4 += 2) {
      f32x4 v, u;
      v[0] = o[dt][4 * i4 + 0]; v[1] = o[dt][4 * i4 + 1]; v[2] = o[dt][4 * i4 + 2]; v[3] = o[dt][4 * i4 + 3];
      u[0] = o[dt][4 * i4 + 4]; u[1] = o[dt][4 * i4 + 5]; u[2] = o[dt][4 * i4 + 6]; u[3] = o[dt][4 * i4 + 7];
      *(u32x4*)(po + dt * 32 + 8 * i4 + 8 * hh) = widen32_pair(pk4(v), pk4(u));
    }
}
DI float* pl_ptr(char* ws, size_t bhq, int slot) { return (float*)(ws + OFF_PL4) + bhq * 4 + slot; }
DI bf16_t* po_slot(char* ws, int slot) { return (bf16_t*)(ws + (slot < 2 ? OFF_PO01 : OFF_PO2)) + (slot < 2 ? (size_t)slot * 24 * SEQ * 128 : 0); }

DI void moba_a_item(const int tid_, const Params& p, LAS char* lds, int item) {
  char* ws = p.ws;
  const int tid = launder(tid_);
  const int w = tid >> 6, lane = tid & 63, r = lane & 31, hh = lane >> 5;
  const int ob = item & 31, bh = item >> 5, h = bh % 6, b = bh / 6;
  LAS int* cnt = (LAS int*)(lds + MA_CNT);
  LAS int* gbase = (LAS int*)(lds + MA_BASE);
  LAS unsigned short* lists = (LAS unsigned short*)(lds + MA_LIST);
  const bf16_t* Q = (const bf16_t*)(ws + OFF_Q);
  const int tokbase = b * SEQ + ob * 256;
  __syncthreads();
  if (tid < 32) cnt[tid] = 0;
  __syncthreads();
  bf16x8 qf[8];
  {
    const bf16_t* qrow = Q + (size_t)(tokbase + 32 * w + r) * AW + h * 128 + 8 * hh;
#pragma unroll
    for (int ks = 0; ks < 8; ++ks) qf[ks] = *(const bf16x8*)(qrow + 16 * ks);
  }
  const float kmaxn = kmax_norm((const float*)(ws + OFF_KMAX2) + bh * 32);
  const float cs_own = sqrtf(qf_norm2(qf)) * kmaxn * ATT_SC;
  if (ob > 0) {
    f32x16 sc;
#pragma unroll
    for (int i = 0; i < 16; ++i) sc[i] = 0.f;
    const bf16_t* kmh = (const bf16_t*)(ws + OFF_KMEAN) + (size_t)bh * 4096 + lane * 8;
#pragma unroll
    for (int ks = 0; ks < 8; ++ks) {
      sc = mfma32(*(const bf16x8*)(kmh + ks * 512), qf[ks], sc);
      sc = mfma32(*(const bf16x8*)(kmh + 98304 + ks * 512), qf[ks], sc);
    }
    T3 t; t.v1 = t.v2 = t.v3 = -INFINITY; t.i1 = t.i2 = t.i3 = 999;
#pragma unroll
    for (int i = 0; i < 16; ++i) { const int blk = crow(i, hh); const bool ok = blk < ob; t = top3_insert(t, ok ? sc[i] : -INFINITY, ok ? blk : 1000); }
    T3 q;
    q.v1 = __shfl_xor(t.v1, 32); q.v2 = __shfl_xor(t.v2, 32); q.v3 = __shfl_xor(t.v3, 32);
    q.i1 = __shfl_xor(t.i1, 32); q.i2 = __shfl_xor(t.i2, 32); q.i3 = __shfl_xor(t.i3, 32);
    t = top3_insert(t, q.v1, q.i1); t = top3_insert(t, q.v2, q.i2); t = top3_insert(t, q.v3, q.i3);
    if (hh == 0) {
      const unsigned qa = (unsigned)(ob * 256 + 32 * w + r) << 2;
      if (t.i1 < 32) { const int sl = atomicAdd((int*)(cnt + t.i1), 1); lists[t.i1 * 256 + sl] = (unsigned short)(qa | 0u); }
      if (t.i2 < 32) { const int sl = atomicAdd((int*)(cnt + t.i2), 1); lists[t.i2 * 256 + sl] = (unsigned short)(qa | 1u); }
      if (t.i3 < 32) { const int sl = atomicAdd((int*)(cnt + t.i3), 1); lists[t.i3 * 256 + sl] = (unsigned short)(qa | 2u); }
    }
  }
  __syncthreads();
  if (tid < ob) { const int n = cnt[tid]; gbase[tid] = n ? (int)atomicAdd((unsigned*)(ws + OFF_GCNT) + bh * 32 + tid, (unsigned)n) : 0; }
  __syncthreads();
  {
    unsigned short* gl = (unsigned short*)(ws + OFF_GLIST) + (size_t)bh * 32 * SEQ;
    for (int j = 0; j < ob; ++j) { if (tid < cnt[j]) gl[(size_t)j * SEQ + gbase[j] + tid] = lists[j * 256 + tid]; }
  }
  {
    f32x16 o[4]; float ls = 0.f;
#pragma unroll
    for (int dt = 0; dt < 4; ++dt)
#pragma unroll
      for (int i = 0; i < 16; ++i) o[dt][i] = 0.f;
    const size_t boff = ((size_t)bh * 256 + ob * 8) * 4096;
    stage_kv_block(tid, (const bf16_t*)(ws + OFF_K) + boff, (const bf16_t*)(ws + OFF_VT) + boff, lds);
    __syncthreads();
    attn_unit_lds<true>(qf, (const LAS bf16_t*)(lds + MB_K) + lane * 8, (const LAS bf16_t*)(lds + MB_V) + lane * 8, w + 1, cs_own, 32 * w + r, hh, o, ls);
    ls += __shfl_xor(ls, 32);
    store_partial((bf16_t*)((char*)p.out + DO_OA) + (size_t)(tokbase + 32 * w + r) * AW + h * 128, o, hh);
    if (hh == 0) *pl_ptr(ws, (size_t)bh * SEQ + ob * 256 + 32 * w + r, 3) = ls;
  }
}

static_assert(MB_END <= LDS_BYTES && MA_END <= LDS_BYTES, "lds");
DI void phase3b(const Params& p, LAS char* lds, const int wv) {
  char* ws = p.ws;
  const int tid0 = make_tid(wv);
  LAS int* pre = (LAS int*)(lds + MB_PRE);
  const unsigned* gcnt = (const unsigned*)(ws + OFF_GCNT);
  __syncthreads();
  {
    const int tid = tid0, w = tid >> 6, lane = tid & 63;
    int c0 = 0, c1 = 0;
    if (tid < 384) { c0 = ((int)gcnt[2 * tid] + 255) >> 8; c1 = ((int)gcnt[2 * tid + 1] + 255) >> 8; }
    int incl = c0 + c1;
#pragma unroll
    for (int d = 1; d < 64; d <<= 1) { const int t = __shfl_up(incl, d); if (lane >= d) incl += t; }
    LAS int* wsum = pre + 768 - 8;
    __syncthreads();
    if (lane == 63) wsum[w] = incl;
    __syncthreads();
    int woff = 0;
    for (int k = 0; k < w; ++k) woff += wsum[k];
    __syncthreads();
    if (tid < 384) { pre[2 * tid] = woff + incl - c1; pre[2 * tid + 1] = woff + incl; }
    __syncthreads();
  }
  const int total = __builtin_amdgcn_readfirstlane(pre[767]);
  const float* kmax2 = (const float*)(ws + OFF_KMAX2);
  const int vblk = ((gridDim.x & 7) == 0) ? (int)((blockIdx.x & 7) * (gridDim.x >> 3) + (blockIdx.x >> 3)) : (int)blockIdx.x;
  const int u_lo = (int)(((long long)vblk * total) / (int)gridDim.x), u_hi = (int)(((long long)(vblk + 1) * total) / (int)gridDim.x);
  int prev_pair = -1;
  for (int u = u_lo; u < u_hi; ++u) {
    const int tid = launder(tid0), w = tid >> 6, lane = tid & 63, r = lane & 31, hh = lane >> 5;
    int lo = 0, hi = 767;
    while (lo < hi) { const int mid = (lo + hi) >> 1; if (pre[mid] > u) hi = mid; else lo = mid + 1; }
    const int pair = __builtin_amdgcn_readfirstlane(lo), bh = pair >> 5, j = pair & 31, h = bh % 6, b = bh / 6;
    const int chunk = __builtin_amdgcn_readfirstlane(u - (pair ? pre[pair - 1] : 0));
    const int n = __builtin_amdgcn_readfirstlane((int)gcnt[pair]);
    if (pair != prev_pair) {
      __syncthreads();
      stage_kv_block(tid, (const bf16_t*)(ws + OFF_K) + ((size_t)bh * 256 + j * 8) * 4096, (const bf16_t*)(ws + OFF_VT) + ((size_t)bh * 256 + j * 8) * 4096, lds);
      __syncthreads();
      prev_pair = pair;
    }
    const int idx = (chunk * 8 + w) * 32 + r;
    if ((chunk * 8 + w) * 32 < n) {
      const unsigned short* gl = (const unsigned short*)(ws + OFF_GLIST) + ((size_t)bh * 32 + j) * SEQ;
      const bool valid = idx < n;
      const unsigned e = gl[valid ? idx : n - 1];
      const int qa = (int)(e >> 2), slot = (int)(e & 3u);
      bf16x8 qf[8];
      {
        const bf16_t* qrow = (const bf16_t*)(ws + OFF_Q) + (size_t)(b * SEQ + qa) * AW + h * 128 + 8 * hh;
#pragma unroll
        for (int ks = 0; ks < 8; ++ks) qf[ks] = *(const bf16x8*)(qrow + 16 * ks);
      }
      const float kmaxn = kmax_norm(kmax2 + bh * 32);
      const float cs = sqrtf(qf_norm2(qf)) * kmaxn * ATT_SC;
      f32x16 o[4]; float ls = 0.f;
#pragma unroll
      for (int dt = 0; dt < 4; ++dt)
#pragma unroll
        for (int i = 0; i < 16; ++i) o[dt][i] = 0.f;
      attn_unit_lds<false>(qf, (const LAS bf16_t*)(lds + MB_K) + lane * 8, (const LAS bf16_t*)(lds + MB_V) + lane * 8, 8, cs, 1 << 30, hh, o, ls);
      ls += __shfl_xor(ls, 32);
      if (valid) {
        store_partial(po_slot(ws, slot) + ((size_t)bh * SEQ + qa) * 128, o, hh);
        if (hh == 0) *pl_ptr(ws, (size_t)bh * SEQ + qa, slot) = ls;
      }
    }
  }
  __syncthreads();
}

DI void phase3c(const Params& p, const int wv) {
  char* ws = p.ws;
  const size_t gt = (size_t)blockIdx.x * NTHREADS + make_tid(wv), NGT = (size_t)gridDim.x * NTHREADS;
  bf16_t* OA = (bf16_t*)((char*)p.out + DO_OA);
  const bf16_t* GA = (const bf16_t*)(ws + OFF_GA);
  const bf16_t* P0 = po_slot(ws, 0); const bf16_t* P1 = po_slot(ws, 1); const bf16_t* P2 = po_slot(ws, 2);
  const f32x4* L4 = (const f32x4*)(ws + OFF_PL4);
  const size_t N = (size_t)MTOK * 6 * 16;
  for (size_t base = gt; base < N; base += NGT * 4) {
    u32x4 vo[4], v0[4], v1[4], v2[4], vg[4]; f32x4 l4[4]; size_t oo[4]; int ns[4];
#pragma unroll
    for (int k = 0; k < 4; ++k) {
      const size_t i0 = base + k * NGT, i = i0 < N ? i0 : gt;
      const int c8 = (int)(i & 15), h = (int)((i >> 4) % 6), tok = (int)((i >> 4) / 6);
      const int b = tok >> 13, q = tok & (SEQ - 1), bh = b * 6 + h;
      ns[k] = min(q >> 8, 3);
      oo[k] = (size_t)tok * AW + h * 128 + c8 * 8;
      const size_t poff = ((size_t)bh * SEQ + q) * 128 + c8 * 8, loff = (size_t)bh * SEQ + q;
      vo[k] = *(const u32x4*)(OA + oo[k]); vg[k] = *(const u32x4*)(GA + oo[k]);
      v0[k] = *(const u32x4*)(P0 + poff); v1[k] = *(const u32x4*)(P1 + poff); v2[k] = *(const u32x4*)(P2 + poff);
      l4[k] = L4[loff];
    }
#pragma unroll
    for (int k = 0; k < 4; ++k) {
      if (base + k * NGT < N) {
        const bool s0 = ns[k] > 0, s1 = ns[k] > 1, s2 = ns[k] > 2;
        const u32x4 a = vo[k], b0 = v0[k], b1 = v1[k], b2 = v2[k], g = vg[k];
        float acc[8] = {bf_lo(a.x), bf_hi(a.x), bf_lo(a.y), bf_hi(a.y), bf_lo(a.z), bf_hi(a.z), bf_lo(a.w), bf_hi(a.w)};
        const float f0[8] = {bf_lo(b0.x), bf_hi(b0.x), bf_lo(b0.y), bf_hi(b0.y), bf_lo(b0.z), bf_hi(b0.z), bf_lo(b0.w), bf_hi(b0.w)};
        const float f1[8] = {bf_lo(b1.x), bf_hi(b1.x), bf_lo(b1.y), bf_hi(b1.y), bf_lo(b1.z), bf_hi(b1.z), bf_lo(b1.w), bf_hi(b1.w)};
        const float f2[8] = {bf_lo(b2.x), bf_hi(b2.x), bf_lo(b2.y), bf_hi(b2.y), bf_lo(b2.z), bf_hi(b2.z), bf_lo(b2.w), bf_hi(b2.w)};
#pragma unroll
        for (int e = 0; e < 8; ++e) acc[e] += (s0 ? f0[e] : 0.f) + (s1 ? f1[e] : 0.f) + (s2 ? f2[e] : 0.f);
        const float l = l4[k][3] + (s0 ? l4[k][0] : 0.f) + (s1 ? l4[k][1] : 0.f) + (s2 ? l4[k][2] : 0.f);
        const float inv = __builtin_amdgcn_rcpf(l);
        u32x4 o;
        o.x = pk2(acc[0] * inv * bf_lo(g.x), acc[1] * inv * bf_hi(g.x)); o.y = pk2(acc[2] * inv * bf_lo(g.y), acc[3] * inv * bf_hi(g.y));
        o.z = pk2(acc[4] * inv * bf_lo(g.z), acc[5] * inv * bf_hi(g.z)); o.w = pk2(acc[6] * inv * bf_lo(g.w), acc[7] * inv * bf_hi(g.w));
        *(u32x4*)(OA + oo[k]) = o;
      }
    }
  }
}

DI void xattn_pair(const int tid_, const Params& p, LAS char* lds, int bhd, int qt0) {
  char* ws = p.ws;
  const int tid = launder(tid_);
  const int w = tid >> 6, lane = tid & 63, r = lane & 31, hh = lane >> 5;
  const int hd = bhd & 3, b = bhd >> 2;
  __syncthreads();
  stage_kv_block(tid, (const bf16_t*)(ws + OFF_MEMK) + (size_t)bhd * 8 * 4096, (const bf16_t*)(ws + OFF_MEMVT) + (size_t)bhd * 8 * 4096, lds);
  __syncthreads();
  const float kmaxn = sqrtf(((const float*)(ws + OFF_MKMAX2))[bhd]);
#pragma unroll 1
  for (int i = 0; i < 2; ++i) {
    const int tok = b * SEQ + (qt0 + i) * 256 + 32 * w + r;
    bf16x8 qf[8];
    {
      const bf16_t* qrow = (const bf16_t*)(ws + OFF_QC) + (size_t)tok * CW + hd * 128 + 8 * hh;
#pragma unroll
      for (int ks = 0; ks < 8; ++ks) qf[ks] = *(const bf16x8*)(qrow + 16 * ks);
    }
    const float cs = sqrtf(qf_norm2(qf)) * kmaxn * ATT_SC;
    f32x16 o[4]; float ls = 0.f;
#pragma unroll
    for (int dt = 0; dt < 4; ++dt)
#pragma unroll
      for (int k = 0; k < 16; ++k) o[dt][k] = 0.f;
    attn_unit_lds<false>(qf, (const LAS bf16_t*)(lds + MB_K) + lane * 8, (const LAS bf16_t*)(lds + MB_V) + lane * 8, 8, cs, 1 << 30, hh, o, ls);
    ls += __shfl_xor(ls, 32);
    const float inv = __builtin_amdgcn_rcpf(ls);
    const bf16_t* gc = (const bf16_t*)(ws + OFF_GC) + (size_t)tok * CW + hd * 128 + 8 * hh;
    bf16_t* oc = (bf16_t*)((char*)p.out + DO_OC) + (size_t)tok * CW + hd * 128 + 8 * hh;
#pragma unroll
    for (int dt = 0; dt < 4; ++dt)
#pragma unroll
      for (int i4 = 0; i4 < 4; i4 += 2) {
        u32x2 ga, gb; unwiden32_pair(*(const u32x4*)(gc + dt * 32 + 8 * i4), ga, gb);
        f32x4 v, u;
        v[0] = o[dt][4 * i4 + 0] * inv * bf_lo(ga.x); v[1] = o[dt][4 * i4 + 1] * inv * bf_hi(ga.x);
        v[2] = o[dt][4 * i4 + 2] * inv * bf_lo(ga.y); v[3] = o[dt][4 * i4 + 3] * inv * bf_hi(ga.y);
        u[0] = o[dt][4 * i4 + 4] * inv * bf_lo(gb.x); u[1] = o[dt][4 * i4 + 5] * inv * bf_hi(gb.x);
        u[2] = o[dt][4 * i4 + 6] * inv * bf_lo(gb.y); u[3] = o[dt][4 * i4 + 7] * inv * bf_hi(gb.y);
        *(u32x4*)(oc + dt * 32 + 8 * i4) = widen32_pair(pk4(v), pk4(u));
      }
  }
}
DI void xattn_item(const int tid, const Params& p, int item) {
  char* ws = p.ws;
  const int w = tid >> 6, lane = tid & 63, r = lane & 31, hh = lane >> 5;
  const int qt = item & 31, bhd = item >> 5, hd = bhd & 3, b = bhd >> 2;
  const int tok = b * SEQ + qt * 256 + 32 * w + r;
  bf16x8 qf[8];
  {
    const bf16_t* qrow = (const bf16_t*)(ws + OFF_QC) + (size_t)tok * CW + hd * 128 + 8 * hh;
#pragma unroll
    for (int ks = 0; ks < 8; ++ks) qf[ks] = *(const bf16x8*)(qrow + 16 * ks);
  }
  const float kmaxn = sqrtf(((const float*)(ws + OFF_MKMAX2))[b * 4 + hd]);
  const float cs = sqrtf(qf_norm2(qf)) * kmaxn * ATT_SC;
  f32x16 o[4]; float ls = 0.f;
#pragma unroll
  for (int dt = 0; dt < 4; ++dt)
#pragma unroll
    for (int i = 0; i < 16; ++i) o[dt][i] = 0.f;
  const size_t boff = (size_t)bhd * 8 * 4096 + lane * 8;
  attn_unit(qf, (const bf16_t*)(ws + OFF_MEMK) + boff, (const bf16_t*)(ws + OFF_MEMVT) + boff, 8, cs, 1 << 30, hh, o, ls);
  ls += __shfl_xor(ls, 32);
  const float inv = 1.f / ls;
  const bf16_t* gc = (const bf16_t*)(ws + OFF_GC) + (size_t)tok * CW + hd * 128 + 4 * hh;
  bf16_t* oc = (bf16_t*)((char*)p.out + DO_OC) + (size_t)tok * CW + hd * 128 + 4 * hh;
#pragma unroll
  for (int dt = 0; dt < 4; ++dt)
#pragma unroll
    for (int i4 = 0; i4 < 4; ++i4) {
      const u32x2 g = *(const u32x2*)(gc + dt * 32 + 8 * i4);
      f32x4 v;
      v[0] = o[dt][4 * i4 + 0] * inv * bf_lo(g.x); v[1] = o[dt][4 * i4 + 1] * inv * bf_hi(g.x);
      v[2] = o[dt][4 * i4 + 2] * inv * bf_lo(g.y); v[3] = o[dt][4 * i4 + 3] * inv * bf_hi(g.y);
      st4(oc + dt * 32 + 8 * i4, v);
    }
}

DI void phase3a(const Params& p, LAS char* lds, const int wv) {
  const int tid = make_tid(wv);
  if (gridDim.x == 256) {
    const int xcd = blockIdx.x & 7, slot = blockIdx.x >> 3;
    for (int i = 0; i < 3; ++i) {
      const int bh = i * 8 + xcd;
      const int ob = (i == 0) ? slot : (i == 1 ? 31 - slot : ((slot + 16) & 31));
      moba_a_item(tid, p, lds, bh * 32 + ob);
    }
    xattn_pair(tid, p, lds, blockIdx.x >> 4, (blockIdx.x & 15) * 2);
  } else {
    for (int it = blockIdx.x; it < 768 + 512; it += gridDim.x) {
      if (it < 768) moba_a_item(tid, p, lds, it);
      else xattn_item(tid, p, it - 768);
    }
  }
}

DI void tile45(int L, int& tt, int& ct) {
  const int G = gridDim.x, b = blockIdx.x;
  if (G == 256) { const int xcd = b & 7, slot = b >> 3; tt = xcd * 16 + 8 * L + (slot & 7); ct = slot >> 3; }
  else { const int t = L * G + b; tt = t >> 2; ct = t & 3; }
}
struct P4Ops { const bf16_t *A, *B; int ld, K; };
DI P4Ops p4_ops(const Params& p, int tok0, int col0, int s) {
  char* ws = p.ws; P4Ops o;
  if (s == 0) { o.A = (const bf16_t*)(ws + OFF_WA) + (size_t)col0 * AW; o.B = (const bf16_t*)((const char*)p.out + DO_OA) + (size_t)tok0 * AW; o.ld = AW; o.K = AW; }
  else if (s == 1) { o.A = (const bf16_t*)(ws + OFF_WB) + (size_t)col0 * AW; o.B = (const bf16_t*)((const char*)p.out + DO_OB) + (size_t)tok0 * AW; o.ld = AW; o.K = AW; }
  else if (s == 2) { o.A = (const bf16_t*)(ws + OFF_WC) + (size_t)col0 * CW; o.B = (const bf16_t*)((const char*)p.out + DO_OC) + (size_t)tok0 * CW; o.ld = CW; o.K = CW; }
  else { o.A = (const bf16_t*)(ws + OFF_WIN) + (size_t)(6400 + (s - 3) * 1024 + col0) * DM; o.B = (const bf16_t*)(ws + OFF_HB) + (size_t)tok0 * DM; o.ld = DM; o.K = DM; }
  return o;
}
DI void phase4(const Params& p, LAS char* lds, const int wv) {
  char* ws = p.ws;
  const int tid = make_tid(wv);
  const int nL = (gridDim.x == 256) ? 2 : (512 + gridDim.x - 1) / gridDim.x;
  int nvalid = 0;
  for (int L = 0; L < nL; ++L) { int tt, ct; tile45(L, tt, ct); if (tt < 128) nvalid = L + 1; }
  if (nvalid == 0) return;
  { int tt, ct; tile45(0, tt, ct); const P4Ops o = p4_ops(p, tt * 256, ct * 256, 0); gemm_begin(tid, o.A, o.B, o.ld, lds); }
#pragma unroll 1
  for (int u = 0; u < nvalid * 6; ++u) {
    const int L = u / 6, s = u - L * 6;
    int tt, ct; tile45(L, tt, ct);
    const int tok0 = tt * 256, col0 = ct * 256;
    const P4Ops o = p4_ops(p, tok0, col0, s);
    const int un = (u + 1 < nvalid * 6) ? u + 1 : u, Ln = un / 6, sn = un - Ln * 6;
    int t2, c2; tile45(Ln, t2, c2);
    const P4Ops nx = p4_ops(p, t2 * 256, c2 * 256, sn);
    f32x4 acc[2][2][4][2];
    gemm_unit(tid, o.A, o.B, o.ld, o.K, nx.A, nx.B, nx.ld, lds, acc);
    if (s < 3) epi_rowmajor(tid, acc, (bf16_t*)(ws + (s == 0 ? OFF_TA : (s == 1 ? OFF_TB : OFF_TC))), DM, tok0, col0, EP_PLAIN, nullptr);
    else epi_gate(tid, acc, (const bf16_t*)(ws + (s == 3 ? OFF_TA : (s == 4 ? OFF_TB : OFF_TC))), (bf16_t*)(ws + OFF_Y), tok0, col0, s == 3);
  }
  gemm_end(tid);
}
DI void phase5(const Params& p, LAS char* lds, const int wv, float* rowss) {
  char* ws = p.ws;
  const int tid = make_tid(wv);
  const int nL = (gridDim.x == 256) ? 2 : (512 + gridDim.x - 1) / gridDim.x;
  int nvalid = 0;
  for (int L = 0; L < nL; ++L) { int tt, ct; tile45(L, tt, ct); if (tt < 128) nvalid = L + 1; }
  if (nvalid == 0) return;
  const bf16_t* WO = (const bf16_t*)(ws + OFF_WO); const bf16_t* Y = (const bf16_t*)(ws + OFF_Y);
  if (tid == 0) *(LAS unsigned*)(lds + 131072 + 8192) = 0u;
  { int tt, ct; tile45(0, tt, ct); gemm_begin(tid, WO + (size_t)ct * 256 * DM, Y + (size_t)tt * 256 * DM, DM, lds); }
#pragma unroll 1
  for (int L = 0; L < nvalid; ++L) {
    int tt, ct; tile45(L, tt, ct);
    int t2, c2; tile45((L + 1 < nvalid) ? L + 1 : L, t2, c2);
    f32x4 acc[2][2][4][2];
    gemm_unit(tid, WO + (size_t)ct * 256 * DM, Y + (size_t)tt * 256 * DM, DM, DM, WO + (size_t)c2 * 256 * DM, Y + (size_t)t2 * 256 * DM, DM, lds, acc);
    const int wr5 = __builtin_amdgcn_readfirstlane(tid >> 8);
    if (wr5 == 0) G_BAR;
    epi_out_norm(tid, acc, p.x, p.out, rowss, (unsigned*)(ws + OFF_C5) + tt, p.final_g, tt * 256, ct * 256, (LAS unsigned*)(lds + 131072 + 8192));
    if (wr5 == 1) G_BAR;
  }
  gemm_end(tid);
}
DI void phase6(const Params& p, const int wv) {
  const size_t gt = (size_t)blockIdx.x * NTHREADS + make_tid(wv), NGT = (size_t)gridDim.x * NTHREADS;
  const float* rowss = (const float*)(p.ws + OFF_ROWSS);
  const size_t N = (size_t)MTOK * (DM / 4);
  f32x4* out4 = (f32x4*)p.out;
  for (size_t base = gt; base < N; base += NGT * 8) {
    f32x4 z[8]; float ss[8];
#pragma unroll
    for (int k = 0; k < 8; ++k) { const size_t i = base + k * NGT; const size_t ic = i < N ? i : gt; z[k] = out4[ic]; ss[k] = rowss[ic >> 8]; }
#pragma unroll
    for (int k = 0; k < 8; ++k) {
      const size_t i = base + k * NGT;
      if (i < N) {
        const float rs = rsqrtf(ss[k] * (1.f / DM) + 1e-6f);
        const f32x4 g = ((const f32x4*)p.final_g)[i & 255];
        f32x4 o; o[0] = z[k][0] * rs * g[0]; o[1] = z[k][1] * rs * g[1]; o[2] = z[k][2] * rs * g[2]; o[3] = z[k][3] * rs * g[3];
        out4[i] = o;
      }
    }
  }
}

__global__ void __launch_bounds__(NTHREADS) fwd_megakernel(Params p) {
  extern __shared__ __attribute__((aligned(16))) char smem_raw[];
  LAS char* lds = (LAS char*)smem_raw;
  cg::grid_group grid = cg::this_grid();
  const int wv = __builtin_amdgcn_readfirstlane((int)threadIdx.x >> 6);
  for (int rep = 0; rep < REP0; ++rep) phase0(p, lds, wv);
  grid.sync();
  unsigned* bar = (unsigned*)(p.ws + OFF_BAR);
  const unsigned G = gridDim.x;
  for (int rep = 0; rep < REP1; ++rep) phase1(p, lds, wv);
  grid_bar(bar, 1u, make_tid(wv));
  for (int rep = 0; rep < REP2; ++rep) phase2(p, lds, wv);
  grid_bar(bar, 2u, make_tid(wv));
  phase3a(p, lds, wv);
  grid_bar(bar, 3u, make_tid(wv));
  for (int rep = 0; rep < REP3; ++rep) phase3b(p, lds, wv);
  grid_bar(bar, 4u, make_tid(wv));
  phase3c(p, wv);
  grid_bar(bar, 5u, make_tid(wv));
  for (int rep = 0; rep < REP4; ++rep) phase4(p, lds, wv);
  grid_bar(bar, 6u, make_tid(wv));
  phase5(p, lds, wv, (float*)(p.ws + OFF_ROWSS));
}

extern "C" void kernel_launch(void* const* d_in, const int* in_sizes, int n_in,
                              void* d_out, int out_size, void* d_ws, size_t ws_size,
                              hipStream_t stream) {
  static int grid_blocks = 0;
  if (!grid_blocks) {
    int dev = 0, cus = 0, per_cu = 0;
    (void)hipGetDevice(&dev);
    (void)hipDeviceGetAttribute(&cus, hipDeviceAttributeMultiprocessorCount, dev);
    (void)hipFuncSetAttribute((const void*)fwd_megakernel, hipFuncAttributeMaxDynamicSharedMemorySize, LDS_BYTES);
    (void)hipOccupancyMaxActiveBlocksPerMultiprocessor(&per_cu, (const void*)fwd_megakernel, NTHREADS, LDS_BYTES);
    if (per_cu < 1) per_cu = 1;
    grid_blocks = cus * per_cu;
    if (ws_size < WS_END3) fprintf(stderr, "kernel_launch: workspace too small: %zu < %zu\n", ws_size, (size_t)WS_END3);
  }
  Params p{};
  p.x = (const float*)d_in[0]; p.mem = (const float*)d_in[1]; p.norm_g = (const float*)d_in[2]; p.mem_norm_g = (const float*)d_in[3];
  p.final_g = (const float*)d_in[4]; p.w_in = (const float*)d_in[5]; p.w_mkv = (const float*)d_in[6]; p.ln_g = (const float*)d_in[7];
  p.w_sp = (const float*)d_in[8]; p.b_sp = (const float*)d_in[9]; p.w_a = (const float*)d_in[10]; p.w_b = (const float*)d_in[11];
  p.w_c = (const float*)d_in[12]; p.w_out = (const float*)d_in[13];
  p.out = (float*)d_out; p.ws = (char*)d_ws;
  void* args[] = {&p};
  hipError_t e = hipLaunchCooperativeKernel((void*)fwd_megakernel, dim3(grid_blocks), dim3(NTHREADS), args, LDS_BYTES, stream);
  if (e != hipSuccess) fprintf(stderr, "cooperative launch failed: %s (grid %d)\n", hipGetErrorString(e), grid_blocks);
}
```

```cpp
#include <hip/hip_runtime.h>
#include <hip/hip_cooperative_groups.h>
#include <cstdio>
#include <cstdint>
namespace cg = cooperative_groups;

#define LAS __attribute__((address_space(3)))
#define DI __device__ __forceinline__

typedef unsigned short bf16_t;
typedef short bf16x8 __attribute__((ext_vector_type(8)));
typedef float f32x2 __attribute__((ext_vector_type(2)));
typedef float f32x4 __attribute__((ext_vector_type(4)));
typedef float f32x16 __attribute__((ext_vector_type(16)));
typedef __bf16 bf16x2_t __attribute__((ext_vector_type(2)));
typedef unsigned u32x2 __attribute__((ext_vector_type(2)));
typedef unsigned u32x4 __attribute__((ext_vector_type(4)));

#define REP0 1
#define REP1 1
#define REP2 1
#define REP2G 1
#define REP3 1
#define REP4 1
#define REP5 1
constexpr int DM = 1024, NB = 4, SEQ = 8192, MTOK = NB * SEQ;
constexpr int AW = 768, CW = 512, INW = 9472;
constexpr int NTHREADS = 512;
constexpr int LDS_BYTES = 152 * 1024;

constexpr size_t MiB = 1u << 20;
constexpr size_t OFF_ROWSS = 0;
constexpr size_t OFF_KMEAN = 131072;
constexpr size_t OFF_KMAX2 = 524288;
constexpr size_t OFF_MKMAX2 = 528384;
constexpr size_t OFF_BAR = 528384 + 1024;
constexpr size_t OFF_GCNT = 528384 + 2048;
constexpr size_t OFF_C5 = 528384 + 2048 + 3072;
constexpr size_t OFF_ROPE = 1 * MiB;
constexpr size_t OFF_HB = 2 * MiB;
constexpr size_t OFF_WIN = 66 * MiB;
constexpr size_t OFF_WMKV = OFF_WIN + (size_t)INW * 1024 * 2;
constexpr size_t OFF_WA = OFF_WMKV + 2 * MiB;
constexpr size_t OFF_WB = OFF_WA + 1536 * 1024;
constexpr size_t OFF_WC = OFF_WB + 1536 * 1024;
constexpr size_t OFF_WO = OFF_WC + 1 * MiB;
constexpr size_t OFF_MEMN = OFF_WO + 2 * MiB;
constexpr size_t OFF_MEMK = OFF_MEMN + 2 * MiB;
constexpr size_t OFF_MEMVT = OFF_MEMK + 1 * MiB;
constexpr size_t OFF_REG = 97 * MiB;
constexpr size_t OFF_Q = OFF_REG;
constexpr size_t OFF_K = OFF_REG + 48 * MiB;
constexpr size_t OFF_VT = OFF_REG + 96 * MiB;
constexpr size_t OFF_VBT = OFF_REG + 144 * MiB;
constexpr size_t OFF_GB = OFF_REG + 192 * MiB;
constexpr size_t OFF_QC = OFF_REG + 240 * MiB;
constexpr size_t OFF_GA = OFF_REG + 272 * MiB;
constexpr size_t OFF_UB = OFF_REG + 320 * MiB;
constexpr size_t OFF_GC = OFF_REG + 368 * MiB;
constexpr size_t WS_END = OFF_REG + 400 * MiB;
constexpr size_t OFF_GLIST = OFF_WIN;
constexpr size_t WS_END2 = WS_END;
static_assert(12 * MiB <= (size_t)6400 * 1024 * 2, "query lists must fit the dead part of the input-projection weights");
constexpr size_t OFF_PO01 = OFF_VBT, OFF_PO2 = OFF_UB;
constexpr size_t OFF_PL01 = OFF_WMKV, OFF_PL23 = OFF_MEMN;
constexpr size_t OFF_PL4 = WS_END2; constexpr size_t WS_END3 = WS_END2 + 3 * MiB;
constexpr size_t OFF_TA = OFF_REG;
constexpr size_t OFF_TB = OFF_REG + 64 * MiB;
constexpr size_t OFF_TC = OFF_REG + 128 * MiB;
constexpr size_t OFF_Y = OFF_REG + 192 * MiB;
static_assert(OFF_MEMVT + 1 * MiB <= OFF_REG, "ws map");
constexpr size_t DO_OA = 0, DO_OC = 48 * MiB, DO_OB = 80 * MiB;

struct Params {
  const float *x, *mem, *norm_g, *mem_norm_g, *final_g, *w_in, *w_mkv, *ln_g, *w_sp, *b_sp, *w_a, *w_b, *w_c, *w_out;
  float* out; char* ws;
};

DI unsigned pk2(float lo, float hi) { f32x2 v = {lo, hi}; return __builtin_bit_cast(unsigned, __builtin_convertvector(v, bf16x2_t)); }
DI float bf_lo(unsigned u) { return __uint_as_float(u << 16); }
DI float bf_hi(unsigned u) { return __uint_as_float(u & 0xffff0000u); }
DI float wave_sum(float v) {
#pragma unroll
  for (int o = 1; o < 64; o <<= 1) v += __shfl_xor(v, o);
  return v;
}
DI float wave_max(float v) {
#pragma unroll
  for (int o = 1; o < 64; o <<= 1) v = fmaxf(v, __shfl_xor(v, o));
  return v;
}
DI float silu_f(float v) { return v * __builtin_amdgcn_rcpf(1.f + __expf(-v)); }
DI float sigmoid_f(float v) { return __builtin_amdgcn_rcpf(1.f + __expf(-v)); }
DI f32x16 mfma32(bf16x8 a, bf16x8 b, f32x16 c) { return __builtin_amdgcn_mfma_f32_32x32x16_bf16(a, b, c, 0, 0, 0); }
DI int crow(int i, int hh) { return (i & 3) + 8 * (i >> 2) + 4 * hh; }
DI int launder(int v) { asm volatile("" : "+v"(v)); return v; }
DI int make_tid(const int wv) { int l; asm volatile("v_mbcnt_lo_u32_b32 %0, -1, 0\n\tv_mbcnt_hi_u32_b32 %0, -1, %0" : "=v"(l)); return wv * 64 + l; }
DI void lds_wait() { asm volatile("s_waitcnt lgkmcnt(0)" ::: "memory"); }

DI void grid_bar(unsigned* ctr, unsigned k, const int tid) {
  __syncthreads();
  if (tid == 0) {
    const unsigned g = blockIdx.x & 7u, gsz = (gridDim.x - g + 7u) >> 3, ngrp = gridDim.x < 8u ? gridDim.x : 8u;
    __builtin_amdgcn_fence(__ATOMIC_RELEASE, "agent");
    const unsigned old = __hip_atomic_fetch_add(ctr + 16 + 16 * g, 1u, __ATOMIC_RELAXED, __HIP_MEMORY_SCOPE_AGENT);
    if (old + 1u == gsz * k) __hip_atomic_fetch_add(ctr, 1u, __ATOMIC_RELAXED, __HIP_MEMORY_SCOPE_AGENT);
    while (__hip_atomic_load(ctr, __ATOMIC_RELAXED, __HIP_MEMORY_SCOPE_AGENT) < ngrp * k) __builtin_amdgcn_s_sleep(2);
    __builtin_amdgcn_fence(__ATOMIC_ACQUIRE, "agent");
  }
  __syncthreads();
}

constexpr int BK = 64, HALF = 128, HTB = HALF * BK * 2;
DI int lds_byte(int r, int c) { int st = (r >> 4) * 2 + (c >> 5), rr = r & 15, cc = c & 31, ob = rr * 64 + cc * 2; return st * 1024 + (ob ^ (((ob >> 9) & 1) << 5)); }
DI void stage_rc(int b, int& R, int& C) { int st = b / 1024, sb = b % 1024, swz = sb ^ (((sb >> 9) & 1) << 5); R = (st >> 1) * 16 + swz / 64; C = (st & 1) * 32 + (swz % 64) / 2; }

DI void gemm_tile(const int tid, const bf16_t* A, const bf16_t* Bm, const int ld, int K, LAS char* lds, f32x4 (&acc)[2][2][4][2]) {
  const int wid = __builtin_amdgcn_readfirstlane(tid >> 6), lane = tid & 63, wr = wid >> 2, wc = wid & 3, fr = lane & 15, fq = lane >> 4;
  unsigned voffA[2];
#pragma unroll
  for (int i = 0; i < 2; ++i) { int R, C; stage_rc(tid * 16 + i * 8192, R, C); voffA[i] = (unsigned)(R * ld + C) * 2u; }
#define voffB voffA
  const unsigned ldsw = (unsigned)wid * 1024u;
  const int aoff = lds_byte(wr * 64 + fr, fq * 8), boff = lds_byte(wc * 32 + fr, fq * 8);
  const char* cA0 = (const char*)A; const char* cA1 = cA0 + (size_t)HALF * ld * 2;
  const char* cB0 = (const char*)Bm; const char* cB1 = cB0 + (size_t)HALF * ld * 2;
#define G_SA(b, h) (((b) * 2 + (h)) * HTB)
#define G_SB(b, h) ((4 + (b) * 2 + (h)) * HTB)
#define G_STAGE(bufoff, gbase, voff, kt) do { _Pragma("unroll") for (int _i = 0; _i < 2; ++_i) \
    __builtin_amdgcn_global_load_lds((const unsigned*)((gbase) + (size_t)(kt) * (BK * 2) + (voff)[_i]), (LAS unsigned*)(lds + (bufoff) + ldsw + _i * 8192), 16, 0, 0); } while (0)
#define G_LDA(dst, b, h) do { _Pragma("unroll") for (int m = 0; m < 4; ++m) _Pragma("unroll") for (int k = 0; k < 2; ++k) dst[m][k] = *(const LAS bf16x8*)(lds + G_SA(b, h) + aoff + m * 2048 + k * 1024); } while (0)
#define G_LDB(dst, b, h) do { _Pragma("unroll") for (int n = 0; n < 2; ++n) _Pragma("unroll") for (int k = 0; k < 2; ++k) dst[n][k] = *(const LAS bf16x8*)(lds + G_SB(b, h) + boff + n * 2048 + k * 1024); } while (0)
#define G_MMA(ai, bj, At, Bt) do { __builtin_amdgcn_s_setprio(1); _Pragma("unroll") for (int m = 0; m < 4; ++m) _Pragma("unroll") for (int n = 0; n < 2; ++n) _Pragma("unroll") for (int k = 0; k < 2; ++k) \
    acc[ai][bj][m][n] = __builtin_amdgcn_mfma_f32_16x16x32_bf16(At[m][k], Bt[n][k], acc[ai][bj][m][n], 0, 0, 0); __builtin_amdgcn_s_setprio(0); } while (0)
#define G_WAIT_V(n) asm volatile("s_waitcnt vmcnt(" #n ")" ::: "memory")
#define G_WAIT_L(n) asm volatile("s_waitcnt lgkmcnt(" #n ")" ::: "memory")
#define G_BAR __builtin_amdgcn_s_barrier()
#define G_SCHED __builtin_amdgcn_sched_barrier(0)
#pragma unroll
  for (int a = 0; a < 2; ++a)
#pragma unroll
    for (int b = 0; b < 2; ++b)
#pragma unroll
      for (int m = 0; m < 4; ++m)
#pragma unroll
        for (int n = 0; n < 2; ++n) acc[a][b][m][n] = (f32x4){0.f, 0.f, 0.f, 0.f};
  bf16x8 At[4][2], B0[2][2], B1[2][2];
  const int nt = K / BK;
  G_WAIT_V(0); G_WAIT_L(0); __syncthreads();
  G_STAGE(G_SB(0, 0), cB0, voffB, 0); G_STAGE(G_SA(0, 0), cA0, voffA, 0);
  G_STAGE(G_SB(0, 1), cB1, voffB, 0); G_STAGE(G_SA(0, 1), cA1, voffA, 0);
  if (wr == 1) G_BAR;
  G_WAIT_V(4); G_BAR;
  G_STAGE(G_SB(1, 0), cB0, voffB, 1); G_STAGE(G_SA(1, 0), cA0, voffA, 1); G_STAGE(G_SB(1, 1), cB1, voffB, 1);
  G_WAIT_V(6); G_BAR;
  for (int t = 0; t < nt - 2; t += 2) {
    G_LDB(B0, 0, 0); G_SCHED; G_LDA(At, 0, 0); G_STAGE(G_SA(1, 1), cA1, voffA, t + 1);
    G_WAIT_L(8); G_BAR; G_WAIT_L(0); G_MMA(0, 0, At, B0); G_BAR; G_SCHED;
    G_LDB(B1, 0, 1); G_STAGE(G_SB(0, 0), cB0, voffB, t + 2);
    G_BAR; G_WAIT_L(0); G_MMA(0, 1, At, B1); G_BAR;
    G_LDA(At, 0, 1); G_STAGE(G_SA(0, 0), cA0, voffA, t + 2);
    G_BAR; G_WAIT_L(0); G_MMA(1, 0, At, B0); G_BAR; G_SCHED;
    G_STAGE(G_SB(0, 1), cB1, voffB, t + 2);
    G_WAIT_V(6); G_BAR; G_MMA(1, 1, At, B1); G_BAR;
    G_LDB(B0, 1, 0); G_SCHED; G_LDA(At, 1, 0); G_STAGE(G_SA(0, 1), cA1, voffA, t + 2);
    G_WAIT_L(8); G_BAR; G_WAIT_L(0); G_MMA(0, 0, At, B0); G_BAR; G_SCHED;
    G_LDB(B1, 1, 1); G_STAGE(G_SB(1, 0), cB0, voffB, t + 3);
    G_BAR; G_WAIT_L(0); G_MMA(0, 1, At, B1); G_BAR;
    G_LDA(At, 1, 1); G_STAGE(G_SA(1, 0), cA0, voffA, t + 3);
    G_BAR; G_WAIT_L(0); G_MMA(1, 0, At, B0); G_BAR; G_SCHED;
    G_STAGE(G_SB(1, 1), cB1, voffB, t + 3);
    G_WAIT_V(6); G_BAR; G_MMA(1, 1, At, B1); G_BAR;
  }
  { G_LDB(B0, 0, 0); G_LDA(At, 0, 0); G_STAGE(G_SA(1, 1), cA1, voffA, nt - 1);
    G_BAR; G_WAIT_L(0); G_MMA(0, 0, At, B0); G_BAR;
    G_LDB(B1, 0, 1); G_BAR; G_WAIT_L(0); G_MMA(0, 1, At, B1); G_BAR;
    G_LDA(At, 0, 1); G_WAIT_V(4); G_BAR; G_WAIT_L(0); G_MMA(1, 0, At, B0); G_MMA(1, 1, At, B1); G_BAR; }
  { G_LDB(B0, 1, 0); G_LDA(At, 1, 0); G_WAIT_V(2); G_BAR; G_WAIT_L(0); G_MMA(0, 0, At, B0); G_BAR;
    G_LDB(B1, 1, 1); G_WAIT_V(0); G_BAR; G_WAIT_L(0); G_MMA(0, 1, At, B1); G_BAR;
    G_LDA(At, 1, 1); G_BAR; G_WAIT_L(0); G_MMA(1, 0, At, B0); G_MMA(1, 1, At, B1); G_BAR; }
  if (wr == 0) G_BAR;
  asm volatile("" ::: "memory");
  G_SCHED;
}

struct GStream { unsigned voff[2]; };
DI void stage_offsets(const int tid, const int ld, unsigned (&voff)[2]) {
#pragma unroll
  for (int i = 0; i < 2; ++i) { int R, C; stage_rc(tid * 16 + i * 8192, R, C); voff[i] = (unsigned)(R * ld + C) * 2u; }
}
#define GS_STAGE(bufoff, gptr, vo) do { _Pragma("unroll") for (int _i = 0; _i < 2; ++_i) \
    __builtin_amdgcn_global_load_lds((const unsigned*)((gptr) + (vo)[_i]), (LAS unsigned*)(lds + (bufoff) + ldsw + _i * 8192), 16, 0, 0); } while (0)
DI void gemm_begin(const int tid, const bf16_t* A, const bf16_t* Bm, const int ld, LAS char* lds) {
  const int wid = __builtin_amdgcn_readfirstlane(tid >> 6), wr = wid >> 2;
  unsigned vo[2]; stage_offsets(tid, ld, vo);
  const unsigned ldsw = (unsigned)wid * 1024u;
  const char* cA = (const char*)A; const char* cB = (const char*)Bm;
  const size_t hstep = (size_t)HALF * ld * 2, kstep = BK * 2;
  __syncthreads();
  GS_STAGE(G_SB(0, 0), cB, vo); GS_STAGE(G_SB(0, 1), cB + hstep, vo); GS_STAGE(G_SA(0, 0), cA, vo); GS_STAGE(G_SA(0, 1), cA + hstep, vo);
  if (wr == 1) G_BAR;
  G_WAIT_V(2); G_BAR;
  GS_STAGE(G_SB(1, 0), cB + kstep, vo); GS_STAGE(G_SA(1, 0), cA + kstep, vo); GS_STAGE(G_SB(1, 1), cB + hstep + kstep, vo);
  G_WAIT_V(6); G_BAR;
}
DI void gemm_end(const int tid) {
  const int wr = __builtin_amdgcn_readfirstlane(tid >> 6) >> 2;
  G_WAIT_V(0);
  if (wr == 0) G_BAR;
  G_BAR;
}
DI void gemm_unit(const int tid, const bf16_t* A, const bf16_t* Bm, const int ld, const int K,
                  const bf16_t* An, const bf16_t* Bn, const int ldn, LAS char* lds, f32x4 (&acc)[2][2][4][2]) {
  const int wid = __builtin_amdgcn_readfirstlane(tid >> 6), lane = tid & 63, wr = wid >> 2, wc = wid & 3, fr = lane & 15, fq = lane >> 4;
  unsigned voC[2], voN[2]; stage_offsets(tid, ld, voC); stage_offsets(tid, ldn, voN);
  const unsigned ldsw = (unsigned)wid * 1024u;
  const int aoff = lds_byte(wr * 64 + fr, fq * 8), boff = lds_byte(wc * 32 + fr, fq * 8);
  const char* cA = (const char*)A; const char* cB = (const char*)Bm;
  const char* nA = (const char*)An; const char* nB = (const char*)Bn;
  const size_t hstepC = (size_t)HALF * ld * 2, hstepN = (size_t)HALF * ldn * 2, kstep = BK * 2;
#pragma unroll
  for (int a = 0; a < 2; ++a)
#pragma unroll
    for (int b = 0; b < 2; ++b)
#pragma unroll
      for (int m = 0; m < 4; ++m)
#pragma unroll
        for (int n = 0; n < 2; ++n) acc[a][b][m][n] = (f32x4){0.f, 0.f, 0.f, 0.f};
  bf16x8 At[4][2], B0[2][2], B1[2][2];
  const int nt = K / BK;
  for (int t = 0; t < nt; t += 2) {
    const bool last = (t == nt - 2);
    const char* a1 = cA + (size_t)(t + 1) * kstep;
    const char* a2 = last ? nA : cA + (size_t)(t + 2) * kstep; const char* b2 = last ? nB : cB + (size_t)(t + 2) * kstep;
    const char* a3 = a2 + kstep; const char* b3 = b2 + kstep;
    const size_t hs2 = last ? hstepN : hstepC;
    unsigned vo2[2]; vo2[0] = last ? voN[0] : voC[0]; vo2[1] = last ? voN[1] : voC[1];
    G_LDB(B0, 0, 0); G_LDB(B1, 0, 1); G_SCHED; G_LDA(At, 0, 0); GS_STAGE(G_SA(1, 1), a1 + hstepC, voC);
    G_WAIT_V(8); G_WAIT_L(0); G_BAR; G_MMA(0, 0, At, B0); G_MMA(0, 1, At, B1); G_BAR; G_SCHED;
    G_LDA(At, 0, 1); GS_STAGE(G_SB(0, 0), b2, vo2); GS_STAGE(G_SB(0, 1), b2 + hs2, vo2); GS_STAGE(G_SA(0, 0), a2, vo2);
    G_WAIT_V(8); G_WAIT_L(0); G_BAR; G_MMA(1, 0, At, B0); G_MMA(1, 1, At, B1); G_BAR; G_SCHED;
    G_LDB(B0, 1, 0); G_LDB(B1, 1, 1); G_SCHED; G_LDA(At, 1, 0); GS_STAGE(G_SA(0, 1), a2 + hs2, vo2);
    G_WAIT_V(8); G_WAIT_L(0); G_BAR; G_MMA(0, 0, At, B0); G_MMA(0, 1, At, B1); G_BAR; G_SCHED;
    G_LDA(At, 1, 1); GS_STAGE(G_SB(1, 0), b3, vo2); GS_STAGE(G_SB(1, 1), b3 + hs2, vo2); GS_STAGE(G_SA(1, 0), a3, vo2);
    G_WAIT_V(8); G_WAIT_L(0); G_BAR; G_MMA(1, 0, At, B0); G_MMA(1, 1, At, B1); G_BAR; G_SCHED;
  }
  asm volatile("" ::: "memory");
  G_SCHED;
}

struct Geo { int wr, wc, fr, fq; };
DI Geo geo(const int tid) { const int wid = tid >> 6, lane = tid & 63; Geo g; g.wr = wid >> 2; g.wc = wid & 3; g.fr = lane & 15; g.fq = lane >> 4; return g; }
DI void st4(bf16_t* p, f32x4 v) { u32x2 o; o.x = pk2(v[0], v[1]); o.y = pk2(v[2], v[3]); *(u32x2*)p = o; }

enum { EP_PLAIN = 0, EP_SILU = 1, EP_ROPE = 2, EP_KFRAG = 4 };
DI u32x4 widen_pair(const u32x2 a, const u32x2 b) {
  const auto r0 = __builtin_amdgcn_permlane16_swap(a.x, b.x, false, false);
  const auto r1 = __builtin_amdgcn_permlane16_swap(a.y, b.y, false, false);
  u32x4 o; o.x = r0[0]; o.y = r1[0]; o.z = r0[1]; o.w = r1[1]; return o;
}
DI void unwiden_pair(const u32x4 w, u32x2& a, u32x2& b) {
  const auto r0 = __builtin_amdgcn_permlane16_swap(w.x, w.z, false, false);
  const auto r1 = __builtin_amdgcn_permlane16_swap(w.y, w.w, false, false);
  a.x = r0[0]; a.y = r1[0]; b.x = r0[1]; b.y = r1[1];
}
DI u32x4 widen32_pair(const u32x2 a, const u32x2 b) {
  const auto r0 = __builtin_amdgcn_permlane32_swap(a.x, b.x, false, false);
  const auto r1 = __builtin_amdgcn_permlane32_swap(a.y, b.y, false, false);
  u32x4 o; o.x = r0[0]; o.y = r1[0]; o.z = r0[1]; o.w = r1[1]; return o;
}
DI void unwiden32_pair(const u32x4 w, u32x2& a, u32x2& b) {
  const auto r0 = __builtin_amdgcn_permlane32_swap(w.x, w.z, false, false);
  const auto r1 = __builtin_amdgcn_permlane32_swap(w.y, w.w, false, false);
  a.x = r0[0]; a.y = r1[0]; b.x = r0[1]; b.y = r1[1];
}
DI u32x2 pk4(const f32x4 v) { u32x2 o; o.x = pk2(v[0], v[1]); o.y = pk2(v[2], v[3]); return o; }
DI void epi_rowmajor(const int tid, f32x4 (&acc)[2][2][4][2], bf16_t* dst, int ld, int tok0, int col0, int mode, const f32x2* rope) {
  const Geo g = geo(launder(tid));
  const int tokb = launder(tok0 + g.wc * 32 + g.fr);
  const int base = tokb * ld + col0 + g.wr * 64 + g.fq * 4;
#pragma unroll
  for (int ai = 0; ai < 2; ++ai)
#pragma unroll
    for (int bj = 0; bj < 2; ++bj)
#pragma unroll
      for (int n = 0; n < 2; ++n) {
        bf16_t* drow = dst + (base + (bj * 128 + n * 16) * ld + ai * 128);
        if ((mode & EP_ROPE) && g.wr == 0) {
          const int tok = tokb + bj * 128 + n * 16;
          const f32x2* cs = rope + (tok & (SEQ - 1)) * 16 + g.fq * 4;
          const f32x4 x1 = acc[ai][bj][0][n], x2 = acc[ai][bj][1][n];
#pragma unroll
          for (int j = 0; j < 4; ++j) { const f32x2 c = cs[j]; acc[ai][bj][0][n][j] = x1[j] * c.x - x2[j] * c.y; acc[ai][bj][1][n][j] = x2[j] * c.x + x1[j] * c.y; }
        }
        if (mode & EP_KFRAG) {
          const int tok = tokb + bj * 128 + n * 16, key = tok & (ld * 32 - 1);
          const int head = (col0 >> 7) + ai;
          bf16_t* kp = dst + ((size_t)((head * ld + (key >> 5)) * 8 + g.wr * 4) * 2 + (g.fq >> 1)) * 256 + (key & 31) * 8 + (g.fq & 1) * 512;
#pragma unroll
          for (int m = 0; m < 4; m += 2) *(u32x4*)(kp + m * 512) = widen_pair(pk4(acc[ai][bj][m][n]), pk4(acc[ai][bj][m + 1][n]));
        } else {
          bf16_t* drow2 = drow + ((g.fq & 1) ? 12 : 0);
#pragma unroll
          for (int m = 0; m < 4; m += 2) {
            f32x4 v = acc[ai][bj][m][n], u = acc[ai][bj][m + 1][n];
            if (mode & EP_SILU) {
              v[0] = silu_f(v[0]); v[1] = silu_f(v[1]); v[2] = silu_f(v[2]); v[3] = silu_f(v[3]);
              u[0] = silu_f(u[0]); u[1] = silu_f(u[1]); u[2] = silu_f(u[2]); u[3] = silu_f(u[3]);
            }
            *(u32x4*)(drow2 + m * 16) = widen_pair(pk4(v), pk4(u));
          }
        }
        __builtin_amdgcn_sched_barrier(0);
      }
}
DI void epi_vfrag(const int tid, f32x4 (&acc)[2][2][4][2], bf16_t* dstF, int ntile, int s0, int head0) {
  const Geo g = geo(launder(tid));
  const int lanepart = launder(((g.fq & 1) * 32 + g.fr) * 8);
#pragma unroll
  for (int ai = 0; ai < 2; ++ai)
#pragma unroll
    for (int bj = 0; bj < 2; ++bj)
#pragma unroll
      for (int m = 0; m < 4; m += 2)
#pragma unroll
        for (int n = 0; n < 2; ++n) {
          const int ms = m + (g.fq >> 1);
          const int kt = (s0 >> 5) + ai * 4 + g.wr * 2 + (ms >> 1);
          const size_t idx = ((size_t)(((head0 + bj) * ntile + kt) * 4 + g.wc) * 2 + (ms & 1)) * 512 + n * 128 + lanepart;
          *(u32x4*)(dstF + idx) = widen32_pair(pk4(acc[ai][bj][m][n]), pk4(acc[ai][bj][m + 1][n]));
        }
}
DI void epi_transposed(const int tid, f32x4 (&acc)[2][2][4][2], bf16_t* dstT, int slen, int s0, int feat0) {
  const Geo g = geo(launder(tid));
  const int featb = launder(feat0 + g.wc * 32 + g.fr);
  const int base = featb * slen + s0 + g.wr * 64 + (g.fq & 1) * 8 + (g.fq >> 1) * 16;
#pragma unroll
  for (int ai = 0; ai < 2; ++ai)
#pragma unroll
    for (int bj = 0; bj < 2; ++bj)
#pragma unroll
      for (int m = 0; m < 4; m += 2)
#pragma unroll
        for (int n = 0; n < 2; ++n)
          *(u32x4*)(dstT + (base + (bj * 128 + n * 16) * slen + ai * 128 + m * 16)) = widen32_pair(pk4(acc[ai][bj][m][n]), pk4(acc[ai][bj][m + 1][n]));
}
DI void epi_gate(const int tid, f32x4 (&acc)[2][2][4][2], const bf16_t* T, bf16_t* Y, int tok0, int col0, bool first) {
  const Geo g = geo(launder(tid));
  const int tokb = launder(tok0 + g.wc * 32 + g.fr);
  const int base = tokb * DM + col0 + g.wr * 64 + g.fq * 4 + ((g.fq & 1) ? 12 : 0);
#pragma unroll
  for (int ai = 0; ai < 2; ++ai)
#pragma unroll
    for (int bj = 0; bj < 2; ++bj)
#pragma unroll
      for (int n = 0; n < 2; ++n)
#pragma unroll
        for (int m = 0; m < 4; m += 2) {
          const int off = base + (bj * 128 + n * 16) * DM + ai * 128 + m * 16;
          u32x2 ta, tb; unwiden_pair(*(const u32x4*)(T + off), ta, tb);
          const f32x4 a = acc[ai][bj][m][n], b = acc[ai][bj][m + 1][n];
          f32x4 ya, yb;
          ya[0] = sigmoid_f(a[0]) * bf_lo(ta.x); ya[1] = sigmoid_f(a[1]) * bf_hi(ta.x); ya[2] = sigmoid_f(a[2]) * bf_lo(ta.y); ya[3] = sigmoid_f(a[3]) * bf_hi(ta.y);
          yb[0] = sigmoid_f(b[0]) * bf_lo(tb.x); yb[1] = sigmoid_f(b[1]) * bf_hi(tb.x); yb[2] = sigmoid_f(b[2]) * bf_lo(tb.y); yb[3] = sigmoid_f(b[3]) * bf_hi(tb.y);
          if (!first) {
            u32x2 oa, ob; unwiden_pair(*(const u32x4*)(Y + off), oa, ob);
            ya[0] += bf_lo(oa.x); ya[1] += bf_hi(oa.x); ya[2] += bf_lo(oa.y); ya[3] += bf_hi(oa.y);
            yb[0] += bf_lo(ob.x); yb[1] += bf_hi(ob.x); yb[2] += bf_lo(ob.y); yb[3] += bf_hi(ob.y);
          }
          *(u32x4*)(Y + off) = widen_pair(pk4(ya), pk4(yb));
        }
}
DI void epi_out(const int tid, f32x4 (&acc)[2][2][4][2], const float* x, float* out, float* rowss, int tok0, int col0) {
  const Geo g = geo(launder(tid));
  const int tokb = launder(tok0 + g.wc * 32 + g.fr);
  const int base = tokb * DM + col0 + g.wr * 64 + g.fq * 4;
#pragma unroll
  for (int bj = 0; bj < 2; ++bj)
#pragma unroll
    for (int n = 0; n < 2; ++n) {
      float ss = 0.f;
#pragma unroll
      for (int ai = 0; ai < 2; ++ai)
#pragma unroll
        for (int m = 0; m < 4; ++m) {
          const int off = base + (bj * 128 + n * 16) * DM + ai * 128 + m * 16;
          const f32x4 xv = *(const f32x4*)(x + off);
          const f32x4 z = xv + acc[ai][bj][m][n];
          *(f32x4*)(out + off) = z;
          ss += z[0] * z[0] + z[1] * z[1] + z[2] * z[2] + z[3] * z[3];
        }
      ss += __shfl_xor(ss, 16); ss += __shfl_xor(ss, 32);
      if (g.fq == 0) atomicAdd(rowss + (tokb + bj * 128 + n * 16), ss);
    }
}

DI void epi_out_norm(const int tid, f32x4 (&acc)[2][2][4][2], const float* x, float* out, float* rowss, unsigned* cnt, const float* gfin,
                     int tok0, int col0, LAS unsigned* lcnt) {
  const Geo g = geo(launder(tid));
  const int lane = tid & 63;
  const int tokb = launder(tok0 + g.wc * 32 + g.fr);
  const int base = tokb * DM + col0 + g.wr * 64 + g.fq * 4;
#pragma unroll
  for (int bj = 0; bj < 2; ++bj)
#pragma unroll
    for (int n = 0; n < 2; ++n) {
      float ss = 0.f;
#pragma unroll
      for (int ai = 0; ai < 2; ++ai)
#pragma unroll
        for (int m = 0; m < 4; ++m) {
          const int off = base + (bj * 128 + n * 16) * DM + ai * 128 + m * 16;
          const f32x4 xv = *(const f32x4*)(x + off);
          const f32x4 z = xv + acc[ai][bj][m][n];
          acc[ai][bj][m][n] = z;
          ss += z[0] * z[0] + z[1] * z[1] + z[2] * z[2] + z[3] * z[3];
        }
      ss += __shfl_xor(ss, 16); ss += __shfl_xor(ss, 32);
      if (g.fq == 0) __hip_atomic_fetch_add(rowss + (tokb + bj * 128 + n * 16), ss, __ATOMIC_RELAXED, __HIP_MEMORY_SCOPE_AGENT);
    }
  asm volatile("s_waitcnt vmcnt(0)" ::: "memory");
  if (lane == 0) {
    const unsigned old = __hip_atomic_fetch_add((unsigned*)lcnt, 1u, __ATOMIC_RELAXED, __HIP_MEMORY_SCOPE_WORKGROUP);
    if (old == 7u) {
      __hip_atomic_store((unsigned*)lcnt, 0u, __ATOMIC_RELAXED, __HIP_MEMORY_SCOPE_WORKGROUP);
      __builtin_amdgcn_fence(__ATOMIC_RELEASE, "agent");
      __hip_atomic_fetch_add(cnt, 1u, __ATOMIC_RELAXED, __HIP_MEMORY_SCOPE_AGENT);
    }
  }
  while (__hip_atomic_load(cnt, __ATOMIC_RELAXED, __HIP_MEMORY_SCOPE_AGENT) < 4u) __builtin_amdgcn_s_sleep(1);
  __builtin_amdgcn_fence(__ATOMIC_ACQUIRE, "agent");
  f32x4 gfv[2][4];
#pragma unroll
  for (int ai = 0; ai < 2; ++ai)
#pragma unroll
    for (int m = 0; m < 4; ++m) gfv[ai][m] = *(const f32x4*)(gfin + col0 + g.wr * 64 + g.fq * 4 + ai * 128 + m * 16);
#pragma unroll
  for (int bj = 0; bj < 2; ++bj)
#pragma unroll
    for (int n = 0; n < 2; ++n) {
      const float tot = __hip_atomic_load(rowss + (tokb + bj * 128 + n * 16), __ATOMIC_RELAXED, __HIP_MEMORY_SCOPE_AGENT);
      const float rs = rsqrtf(tot * (1.f / DM) + 1e-6f);
#pragma unroll
      for (int ai = 0; ai < 2; ++ai)
#pragma unroll
        for (int m = 0; m < 4; ++m) {
          const int off = base + (bj * 128 + n * 16) * DM + ai * 128 + m * 16;
          const f32x4 gg = gfv[ai][m];
          const f32x4 z = acc[ai][bj][m][n];
          f32x4 o; o[0] = z[0] * rs * gg[0]; o[1] = z[1] * rs * gg[1]; o[2] = z[2] * rs * gg[2]; o[3] = z[3] * rs * gg[3];
          *(f32x4*)(out + off) = o;
        }
    }
}

DI void p0_transpose_item(const float* W, int K, int N, bf16_t* WT, LAS float* scr, int item, int lane) {
  const int nblk = N / 32, kb = item / nblk, nb = item % nblk, k0 = 64 * kb, n0 = 32 * nb;
#pragma unroll 8
  for (int i = 0; i < 32; ++i) { const int kk = 2 * i + (lane >> 5); scr[kk * 33 + (lane & 31)] = W[(size_t)(k0 + kk) * N + n0 + (lane & 31)]; }
  lds_wait();
  const int c = lane & 7;
#pragma unroll
  for (int j = 0; j < 4; ++j) {
    const int n = (lane >> 3) + 8 * j; const LAS float* s = scr + (8 * c) * 33 + n;
    u32x4 o; o.x = pk2(s[0 * 33], s[1 * 33]); o.y = pk2(s[2 * 33], s[3 * 33]); o.z = pk2(s[4 * 33], s[5 * 33]); o.w = pk2(s[6 * 33], s[7 * 33]);
    *(u32x4*)(WT + (size_t)(n0 + n) * K + k0 + 8 * c) = o;
  }
  lds_wait();
}
DI void rms_row_bf16(const float* xr, const float* gw, bf16_t* orow, int lane) {
  f32x4 v[4]; float s = 0.f;
#pragma unroll
  for (int j = 0; j < 4; ++j) { v[j] = ((const f32x4*)xr)[lane + 64 * j]; s += v[j][0] * v[j][0] + v[j][1] * v[j][1] + v[j][2] * v[j][2] + v[j][3] * v[j][3]; }
  s = wave_sum(s);
  const float rs = rsqrtf(s * (1.f / DM) + 1e-6f);
#pragma unroll
  for (int j = 0; j < 4; ++j) {
    const f32x4 gg = ((const f32x4*)gw)[lane + 64 * j];
    u32x2 o; o.x = pk2(v[j][0] * rs * gg[0], v[j][1] * rs * gg[1]); o.y = pk2(v[j][2] * rs * gg[2], v[j][3] * rs * gg[3]);
    *(u32x2*)(orow + 4 * (lane + 64 * j)) = o;
  }
}
DI void phase0(const Params& p, LAS char* lds, const int wv) {
  const int tid = make_tid(wv), wave = tid >> 6, lane = tid & 63, G = gridDim.x;
  const int gw = blockIdx.x * 8 + wave, NGW = G * 8;
  const size_t gt = (size_t)blockIdx.x * NTHREADS + tid, NGT = (size_t)G * NTHREADS;
  char* ws = p.ws;
  if (gt < 144) ((unsigned*)(ws + OFF_BAR))[gt] = 0u;
  if (gt < 24 * 32) ((unsigned*)(ws + OFF_GCNT))[gt] = 0u;
  if (gt < 128) ((unsigned*)(ws + OFF_C5))[gt] = 0u;
  for (size_t i = gt; i < MTOK; i += NGT) ((float*)(ws + OFF_ROWSS))[i] = 0.f;
  for (size_t i = gt; i < (size_t)SEQ * 16; i += NGT) {
    const int pos = (int)(i >> 4), f = (int)(i & 15);
    const float inv = powf(500000.0f, -(float)f * (1.f / 16.f));
    const float ang = (float)pos * inv;
    f32x2 cs; cs.x = cosf(ang); cs.y = sinf(ang);
    ((f32x2*)(ws + OFF_ROPE))[i] = cs;
  }
  f32x4 gx[4];
#pragma unroll
  for (int j = 0; j < 2; ++j) { gx[2 * j] = ((const f32x4*)p.norm_g)[2 * (lane + 64 * j)]; gx[2 * j + 1] = ((const f32x4*)p.norm_g)[2 * (lane + 64 * j) + 1]; }
  for (int r0 = gw; r0 < MTOK + NB * 256; r0 += 4 * NGW) {
    f32x4 v[4][4]; float ss[4]; bf16_t* osel[4]; bool ok[4], ismem[4];
#pragma unroll
    for (int k = 0; k < 4; ++k) {
      const int r = r0 + k * NGW;
      ok[k] = r < MTOK + NB * 256;
      const int rc = ok[k] ? r : r0;
      const float* xr;
      ismem[k] = rc >= MTOK;
      if (!ismem[k]) { xr = p.x + (size_t)rc * DM; osel[k] = (bf16_t*)(ws + OFF_HB) + (size_t)rc * DM; }
      else { const int m = rc - MTOK; xr = p.mem + (size_t)m * DM; osel[k] = (bf16_t*)(ws + OFF_MEMN) + (size_t)m * DM; }
#pragma unroll
      for (int j = 0; j < 2; ++j) { v[k][2 * j] = ((const f32x4*)xr)[2 * (lane + 64 * j)]; v[k][2 * j + 1] = ((const f32x4*)xr)[2 * (lane + 64 * j) + 1]; }
    }
#pragma unroll
    for (int k = 0; k < 4; ++k) {
      float s_ = 0.f;
#pragma unroll
      for (int j = 0; j < 4; ++j) s_ += v[k][j][0] * v[k][j][0] + v[k][j][1] * v[k][j][1] + v[k][j][2] * v[k][j][2] + v[k][j][3] * v[k][j][3];
      ss[k] = s_;
    }
#pragma unroll
    for (int o = 1; o < 64; o <<= 1) {
#pragma unroll
      for (int k = 0; k < 4; ++k) ss[k] += __shfl_xor(ss[k], o);
    }
#pragma unroll
    for (int k = 0; k < 4; ++k) {
      if (ok[k]) {
        const float rs = rsqrtf(ss[k] * (1.f / DM) + 1e-6f);
#pragma unroll
        for (int j = 0; j < 2; ++j) {
          f32x4 g0 = gx[2 * j], g1 = gx[2 * j + 1];
          if (ismem[k]) { g0 = ((const f32x4*)p.mem_norm_g)[2 * (lane + 64 * j)]; g1 = ((const f32x4*)p.mem_norm_g)[2 * (lane + 64 * j) + 1]; }
          const f32x4 a = v[k][2 * j], c = v[k][2 * j + 1];
          u32x4 o; o.x = pk2(a[0] * rs * g0[0], a[1] * rs * g0[1]); o.y = pk2(a[2] * rs * g0[2], a[3] * rs * g0[3]);
          o.z = pk2(c[0] * rs * g1[0], c[1] * rs * g1[1]); o.w = pk2(c[2] * rs * g1[2], c[3] * rs * g1[3]);
          *(u32x4*)(osel[k] + 8 * (lane + 64 * j)) = o;
        }
      }
    }
  }
  LAS float* scr = (LAS float*)(lds + wave * 8448);
  constexpr int I_IN = 16 * (INW / 32), I_MKV = 16 * 32, I_A = 12 * 32, I_C = 8 * 32, I_O = 16 * 32;
  constexpr int NITEMS = I_IN + I_MKV + 2 * I_A + I_C + I_O;
  for (int it = gw; it < NITEMS; it += NGW) {
    int r = it;
    if (r < I_IN) { p0_transpose_item(p.w_in, 1024, INW, (bf16_t*)(ws + OFF_WIN), scr, r, lane); continue; } r -= I_IN;
    if (r < I_MKV) { p0_transpose_item(p.w_mkv, 1024, 1024, (bf16_t*)(ws + OFF_WMKV), scr, r, lane); continue; } r -= I_MKV;
    if (r < I_A) { p0_transpose_item(p.w_a, 768, 1024, (bf16_t*)(ws + OFF_WA), scr, r, lane); continue; } r -= I_A;
    if (r < I_A) { p0_transpose_item(p.w_b, 768, 1024, (bf16_t*)(ws + OFF_WB), scr, r, lane); continue; } r -= I_A;
    if (r < I_C) { p0_transpose_item(p.w_c, 512, 1024, (bf16_t*)(ws + OFF_WC), scr, r, lane); continue; } r -= I_C;
    p0_transpose_item(p.w_out, 1024, 1024, (bf16_t*)(ws + OFF_WO), scr, r, lane);
  }
}

struct P1Ops { const bf16_t *A, *B; int tt, ct; bool memkv, tr; };
DI P1Ops p1_ops(char* ws, int L, bool swz, int xcd) {
  P1Ops o;
  if (swz) {
    if (L < 400) { const int grp = L / 200, r = L % 200; o.tt = xcd * 16 + grp * 8 + (r & 7); o.ct = r >> 3; o.memkv = false; }
    else { o.memkv = true; const int t = xcd * 2 + (L - 400); o.tt = t >> 2; o.ct = t & 3; }
  } else {
    if (L < 3200) { o.tt = L / 25; o.ct = L % 25; o.memkv = false; } else { o.memkv = true; o.tt = (L - 3200) >> 2; o.ct = (L - 3200) & 3; }
  }
  const bf16_t *Wt, *Xt;
  if (!o.memkv) {
    Wt = (const bf16_t*)(ws + OFF_WIN) + (size_t)o.ct * 256 * DM; Xt = (const bf16_t*)(ws + OFF_HB) + (size_t)o.tt * 256 * DM;
    o.tr = (o.ct >= 6 && o.ct < 9) || (o.ct >= 15 && o.ct < 18);
  } else {
    Wt = (const bf16_t*)(ws + OFF_WMKV) + (size_t)o.ct * 256 * DM; Xt = (const bf16_t*)(ws + OFF_MEMN) + (size_t)o.tt * 256 * DM;
    o.tr = o.ct >= 2;
  }
  o.A = o.tr ? Xt : Wt; o.B = o.tr ? Wt : Xt;
  return o;
}
DI void phase1(const Params& p, LAS char* lds, const int wv) {
  char* ws = p.ws;
  const int tid = make_tid(wv);
  const int G = gridDim.x, b = blockIdx.x;
  const f32x2* rope = (const f32x2*)(ws + OFF_ROPE);
  const bool swz = (G % 8) == 0;
  const int per = swz ? G / 8 : G, xcd = swz ? (b & 7) : 0, slot = swz ? (b >> 3) : b;
  const int LMAX = swz ? 402 : 3216;
  if (slot >= LMAX) return;
  { const P1Ops o = p1_ops(ws, slot, swz, xcd); gemm_begin(tid, o.A, o.B, DM, lds); }
  for (int L = slot; L < LMAX; L += per) {
    const P1Ops o = p1_ops(ws, L, swz, xcd);
    const P1Ops nx = p1_ops(ws, (L + per < LMAX) ? L + per : L, swz, xcd);
    const int tt = o.tt, ct = o.ct; const bool tr = o.tr;
    bf16_t* dst; int dld, dcol, mode, slen, s0, tok0;
    if (!o.memkv) {
      tok0 = tt * 256; slen = SEQ; s0 = (tt & 31) * 256;
      const int bb = tt >> 5;
      if (ct < 3) { dst = (bf16_t*)(ws + OFF_Q); dld = AW; dcol = ct * 256; mode = EP_ROPE; }
      else if (ct < 6) { dst = (bf16_t*)(ws + OFF_K) + (size_t)bb * 6 * 256 * 4096; dld = 256; dcol = (ct - 3) * 256; mode = EP_ROPE | EP_KFRAG; }
      else if (ct < 9) { dst = (bf16_t*)(ws + OFF_VT) + (size_t)bb * 6 * 256 * 4096; dld = 1; dcol = (ct - 6) * 2; mode = EP_PLAIN; }
      else if (ct < 12) { dst = (bf16_t*)(ws + OFF_GA); dld = AW; dcol = (ct - 9) * 256; mode = EP_SILU; }
      else if (ct < 15) { dst = (bf16_t*)(ws + OFF_UB); dld = AW; dcol = (ct - 12) * 256; mode = EP_PLAIN; }
      else if (ct < 18) { dst = (bf16_t*)(ws + OFF_VBT) + (size_t)bb * AW * SEQ; dld = 0; dcol = (ct - 15) * 256; mode = EP_PLAIN; }
      else if (ct < 21) { dst = (bf16_t*)(ws + OFF_GB); dld = AW; dcol = (ct - 18) * 256; mode = EP_SILU; }
      else if (ct < 23) { dst = (bf16_t*)(ws + OFF_QC); dld = CW; dcol = (ct - 21) * 256; mode = EP_PLAIN; }
      else { dst = (bf16_t*)(ws + OFF_GC); dld = CW; dcol = (ct - 23) * 256; mode = EP_SILU; }
    } else {
      tok0 = tt * 256; slen = 256; s0 = 0; mode = EP_PLAIN;
      if (!tr) { dst = (bf16_t*)(ws + OFF_MEMK) + (size_t)tt * 4 * 8 * 4096; dld = 8; dcol = ct * 256; mode = EP_KFRAG; }
      else { dst = (bf16_t*)(ws + OFF_MEMVT) + (size_t)tt * 4 * 8 * 4096; dld = 1; dcol = (ct - 2) * 2; }
    }
    f32x4 acc[2][2][4][2];
    gemm_unit(tid, o.A, o.B, DM, DM, nx.A, nx.B, DM, lds, acc);
    if (!tr) epi_rowmajor(tid, acc, dst, dld, tok0, dcol, mode, rope);
    else if (dld == 1) epi_vfrag(tid, acc, dst, slen >> 5, s0, dcol);
    else epi_transposed(tid, acc, dst, slen, s0, dcol);
  }
  gemm_end(tid);
}

DI void kstat_item(const int tid, const bf16_t* blk, bf16_t* kmh, const int blkidx, float* max2_out, LAS char* lds) {
  const int ks = tid >> 6, lane = tid & 63;
  LAS float* n2p = (LAS float*)lds;
  LAS float* redm = n2p + 4096;
  __syncthreads();
  float cs[8];
#pragma unroll
  for (int e = 0; e < 8; ++e) cs[e] = 0.f;
#pragma unroll
  for (int kt = 0; kt < 8; ++kt) {
    const u32x4 v = *(const u32x4*)(blk + (size_t)((kt * 8 + ks) * 64 + lane) * 8);
    const float f[8] = {bf_lo(v.x), bf_hi(v.x), bf_lo(v.y), bf_hi(v.y), bf_lo(v.z), bf_hi(v.z), bf_lo(v.w), bf_hi(v.w)};
    float n2 = 0.f;
#pragma unroll
    for (int e = 0; e < 8; ++e) { cs[e] += f[e]; n2 += f[e] * f[e]; }
    n2p[(ks * 2 + (lane >> 5)) * 256 + kt * 32 + (lane & 31)] = n2;
  }
#pragma unroll
  for (int e = 0; e < 8; ++e) {
    float c = cs[e];
    c += __shfl_xor(c, 1); c += __shfl_xor(c, 2); c += __shfl_xor(c, 4); c += __shfl_xor(c, 8); c += __shfl_xor(c, 16);
    cs[e] = c * (1.f / 256.f);
  }
  if (kmh && (lane & 31) == 0) {
    u32x4 hi, lo;
    hi.x = pk2(cs[0], cs[1]); hi.y = pk2(cs[2], cs[3]); hi.z = pk2(cs[4], cs[5]); hi.w = pk2(cs[6], cs[7]);
    lo.x = pk2(cs[0] - bf_lo(hi.x), cs[1] - bf_hi(hi.x)); lo.y = pk2(cs[2] - bf_lo(hi.y), cs[3] - bf_hi(hi.y));
    lo.z = pk2(cs[4] - bf_lo(hi.z), cs[5] - bf_hi(hi.z)); lo.w = pk2(cs[6] - bf_lo(hi.w), cs[7] - bf_hi(hi.w));
    bf16_t* d = kmh + ((size_t)(ks * 64 + (lane >> 5) * 32 + blkidx)) * 8;
    *(u32x4*)d = hi; *(u32x4*)(d + 98304) = lo;
  }
  __syncthreads();
  if (tid < 256) {
    float n = 0.f;
#pragma unroll
    for (int k = 0; k < 16; ++k) n += n2p[k * 256 + tid];
    n = wave_max(n);
    if ((tid & 63) == 0) redm[tid >> 6] = n;
  }
  __syncthreads();
  if (tid == 0) *max2_out = fmaxf(fmaxf(redm[0], redm[1]), fmaxf(redm[2], redm[3]));
  __syncthreads();
}

DI u32x4 pack_w(const f32x4 wa, const f32x4 wb) { u32x4 o; o.x = pk2(wa[0], wa[1]); o.y = pk2(wa[2], wa[3]); o.z = pk2(wb[0], wb[1]); o.w = pk2(wb[2], wb[3]); return o; }
DI u32x4 pack_w_masked(const f32x4 wa, const f32x4 wb, const int sa, const int t) {
  u32x4 o; const int sb = sa + 8;
  o.x = pk2(sa + 0 <= t ? wa[0] : 0.f, sa + 1 <= t ? wa[1] : 0.f); o.y = pk2(sa + 2 <= t ? wa[2] : 0.f, sa + 3 <= t ? wa[3] : 0.f);
  o.z = pk2(sb + 0 <= t ? wb[0] : 0.f, sb + 1 <= t ? wb[1] : 0.f); o.w = pk2(sb + 2 <= t ? wb[2] : 0.f, sb + 3 <= t ? wb[3] : 0.f);
  return o;
}
DI void gmlp_item(const int tid, const Params& p, LAS char* lds, int item) {
  char* ws = p.ws;
  const int w = tid >> 6, lane = tid & 63, r = lane & 31, hh = lane >> 5;
  const int b = item >> 6, ch = item & 63, s0 = ch * 128, tok0 = b * SEQ + s0;
  const bf16_t* VBT = (const bf16_t*)(ws + OFF_VBT) + (size_t)b * AW * SEQ + s0;
  LAS float* red = (LAS float*)lds;
  LAS float* red2 = red + 4096;
  LAS float* ra = red + 8192;
  LAS float* rb = ra + 128;
  __syncthreads();
  {
    const int oct = tid & 15, cpart = tid >> 4;
    float sum[8], sq[8];
#pragma unroll
    for (int e = 0; e < 8; ++e) { sum[e] = 0.f; sq[e] = 0.f; }
#pragma unroll 8
    for (int i = 0; i < 24; ++i) {
      const u32x4 v = *(const u32x4*)(VBT + (size_t)(cpart + 32 * i) * SEQ + oct * 8);
      const float f[8] = {bf_lo(v.x), bf_hi(v.x), bf_lo(v.y), bf_hi(v.y), bf_lo(v.z), bf_hi(v.z), bf_lo(v.w), bf_hi(v.w)};
#pragma unroll
      for (int e = 0; e < 8; ++e) { sum[e] += f[e]; sq[e] += f[e] * f[e]; }
    }
#pragma unroll
    for (int e = 0; e < 8; ++e) { red[cpart * 128 + oct * 8 + e] = sum[e]; red2[cpart * 128 + oct * 8 + e] = sq[e]; }
    __syncthreads();
    if (tid < 128) {
      float su = 0.f, s2 = 0.f;
#pragma unroll 8
      for (int k = 0; k < 32; ++k) { su += red[k * 128 + tid]; s2 += red2[k * 128 + tid]; }
      const float mu = su * (1.f / AW); const float var = fmaxf(s2 * (1.f / AW) - mu * mu, 0.f);
      const float rr = rsqrtf(var + 1e-6f);
      ra[tid] = rr; rb[tid] = mu * rr;
    }
    __syncthreads();
  }
  const int ct = w & 3, gh = w >> 2;
  const bf16_t* UB = (const bf16_t*)(ws + OFF_UB);
  bf16_t* OB = (bf16_t*)((char*)p.out + DO_OB);
  const bf16_t* GB = (const bf16_t*)(ws + OFF_GB);
#pragma unroll 1
  for (int it = 0; it < 3; ++it) {
    const int g = gh * 3 + it;
    f32x16 acc[4];
#pragma unroll
    for (int T = 0; T < 4; ++T)
#pragma unroll
      for (int i = 0; i < 16; ++i) acc[T][i] = 0.f;
    const int c = g * 128 + ct * 32 + r;
    const float lgc = p.ln_g[c];
    const float* wrow = p.w_sp + ((size_t)g * 128 + r) * 128;
#pragma unroll
    for (int ks = 0; ks < 8; ++ks) {
      const u32x4 raw = *(const u32x4*)(VBT + (size_t)c * SEQ + 16 * ks + 8 * hh);
      const f32x4 r0 = *(const LAS f32x4*)(ra + 16 * ks + 8 * hh), r1 = *(const LAS f32x4*)(ra + 16 * ks + 8 * hh + 4);
      const f32x4 m0 = *(const LAS f32x4*)(rb + 16 * ks + 8 * hh), m1 = *(const LAS f32x4*)(rb + 16 * ks + 8 * hh + 4);
      u32x4 a;
      a.x = pk2((bf_lo(raw.x) * r0[0] - m0[0]) * lgc, (bf_hi(raw.x) * r0[1] - m0[1]) * lgc);
      a.y = pk2((bf_lo(raw.y) * r0[2] - m0[2]) * lgc, (bf_hi(raw.y) * r0[3] - m0[3]) * lgc);
      a.z = pk2((bf_lo(raw.z) * r1[0] - m1[0]) * lgc, (bf_hi(raw.z) * r1[1] - m1[1]) * lgc);
      a.w = pk2((bf_lo(raw.w) * r1[2] - m1[2]) * lgc, (bf_hi(raw.w) * r1[3] - m1[3]) * lgc);
      const bf16x8 af = __builtin_bit_cast(bf16x8, a);
      const int sa = 16 * ks + 4 * hh;
#pragma unroll
      for (int T = 0; T < 4; ++T) {
        if (ks <= 2 * T + 1) {
          const float* wt = wrow + T * 32 * 128;
          const f32x4 wa = *(const f32x4*)(wt + sa), wb = *(const f32x4*)(wt + sa + 8);
          const u32x4 bb = (ks >= 2 * T) ? pack_w_masked(wa, wb, sa, T * 32 + r) : pack_w(wa, wb);
          acc[T] = mfma32(af, __builtin_bit_cast(bf16x8, bb), acc[T]);
        }
      }
      if (ks & 1) __builtin_amdgcn_sched_barrier(0);
    }
#pragma unroll
    for (int T = 0; T < 4; ++T) {
      const int t = T * 32 + r;
      const float bias = p.b_sp[g * 128 + t];
      const size_t rowoff = (size_t)(tok0 + t) * AW + g * 128 + ct * 32 + 8 * hh;
#pragma unroll
      for (int i4 = 0; i4 < 4; i4 += 2) {
        const size_t off = rowoff + 8 * i4;
        u32x2 ua, ub2, ga, gb2;
        unwiden32_pair(*(const u32x4*)(UB + off), ua, ub2);
        unwiden32_pair(*(const u32x4*)(GB + off), ga, gb2);
        f32x4 oa, ob;
#pragma unroll
        for (int e = 0; e < 4; ++e) {
          const float a0 = acc[T][4 * i4 + e], a1 = acc[T][4 * i4 + 4 + e];
          const unsigned uw0 = (e < 2) ? ua.x : ua.y, gw0 = (e < 2) ? ga.x : ga.y, uw1 = (e < 2) ? ub2.x : ub2.y, gw1 = (e < 2) ? gb2.x : gb2.y;
          const float u0 = (e & 1) ? bf_hi(uw0) : bf_lo(uw0), g0 = (e & 1) ? bf_hi(gw0) : bf_lo(gw0);
          const float u1 = (e & 1) ? bf_hi(uw1) : bf_lo(uw1), g1 = (e & 1) ? bf_hi(gw1) : bf_lo(gw1);
          oa[e] = u0 * (a0 + bias) * g0; ob[e] = u1 * (a1 + bias) * g1;
        }
        *(u32x4*)(OB + off) = widen32_pair(pk4(oa), pk4(ob));
      }
    }
  }
}

DI void phase2(const Params& p, LAS char* lds, const int wv) {
  char* ws = p.ws;
  const int tid = make_tid(wv);
  for (int it = blockIdx.x; it < 256 + 768 + 16; it += gridDim.x) {
    if (it < 256) { for (int rg = 0; rg < REP2G; ++rg) gmlp_item(tid, p, lds, it); }
    else if (it < 1024) {
      const int k = it - 256, blk = k & 31, bh = k >> 5, h = bh % 6, b = bh / 6;
      kstat_item(tid, (const bf16_t*)(ws + OFF_K) + ((size_t)bh * 256 + blk * 8) * 4096,
                 (bf16_t*)(ws + OFF_KMEAN) + (size_t)bh * 4096, blk, (float*)(ws + OFF_KMAX2) + k, lds);
    } else {
      const int k = it - 1024, hd = k & 3, b = k >> 2;
      kstat_item(tid, (const bf16_t*)(ws + OFF_MEMK) + (size_t)k * 8 * 4096, nullptr, 0, (float*)(ws + OFF_MKMAX2) + k, lds);
    }
  }
}

constexpr float ATT_SC = 0.08838834764831845f * 1.4426950408889634f;
DI bf16x8 ldfrag(const bf16_t* p) { return *(const bf16x8*)p; }
DI bf16x8 ldfrag(const LAS bf16_t* p) { return *(const LAS bf16x8*)p; }
template <class KP>
DI void attn_unit(const bf16x8 (&qf)[8], KP Kt, KP Vt, int nkt, float cs, int qpos, int hh, f32x16 (&o)[4], float& lsum) {
  bf16x8 kf[8], vf[8];
#pragma unroll
  for (int f = 0; f < 8; ++f) kf[f] = ldfrag(Kt + f * 512);
#pragma unroll
  for (int f = 0; f < 8; ++f) vf[f] = ldfrag(Vt + f * 512);
#pragma unroll 1
  for (int kt = 0; kt < nkt; ++kt) {
    f32x16 s;
#pragma unroll
    for (int i = 0; i < 16; ++i) s[i] = 0.f;
#pragma unroll
    for (int ks = 0; ks < 8; ++ks) s = mfma32(kf[ks], qf[ks], s);
    const int ktn = (kt + 1 < nkt) ? kt + 1 : kt;
#pragma unroll
    for (int f = 0; f < 8; ++f) kf[f] = ldfrag(Kt + ktn * 4096 + f * 512);
#pragma unroll
    for (int i = 0; i < 16; ++i) {
      const int key = kt * 32 + crow(i, hh);
      float pv = __builtin_amdgcn_exp2f(s[i] * ATT_SC - cs);
      pv = key > qpos ? 0.f : pv;
      lsum += pv; s[i] = pv;
    }
    u32x4 a, b;
    a.x = pk2(s[0], s[1]); a.y = pk2(s[2], s[3]); a.z = pk2(s[4], s[5]); a.w = pk2(s[6], s[7]);
    b.x = pk2(s[8], s[9]); b.y = pk2(s[10], s[11]); b.z = pk2(s[12], s[13]); b.w = pk2(s[14], s[15]);
    const bf16x8 p0 = __builtin_bit_cast(bf16x8, a), p1 = __builtin_bit_cast(bf16x8, b);
#pragma unroll
    for (int dt = 0; dt < 4; ++dt) { o[dt] = mfma32(vf[dt * 2], p0, o[dt]); o[dt] = mfma32(vf[dt * 2 + 1], p1, o[dt]); }
#pragma unroll
    for (int f = 0; f < 8; ++f) vf[f] = ldfrag(Vt + ktn * 4096 + f * 512);
  }
}
template <bool CAUSAL>
DI void attn_unit_lds(const bf16x8 (&qf)[8], const LAS bf16_t* Kt, const LAS bf16_t* Vt, const int nkt, float cs, const int qpos, const int hh, f32x16 (&o)[4], float& lsum) {
  f32x16 zero;
#pragma unroll
  for (int i = 0; i < 16; ++i) zero[i] = 0.f;
  const f32x2 sc2 = {ATT_SC, ATT_SC}, cs2 = {cs, cs};
  f32x2 l2 = {0.f, 0.f};
#pragma unroll 1
  for (int kt = 0; kt < nkt; ++kt) {
    f32x16 s = mfma32(*(const LAS bf16x8*)(Kt + kt * 4096), qf[0], zero);
#pragma unroll
    for (int ks = 1; ks < 8; ++ks) { const bf16x8 kf = *(const LAS bf16x8*)(Kt + kt * 4096 + ks * 512); s = mfma32(kf, qf[ks], s); }
    u32x4 a, b;
    unsigned pk[8];
#pragma unroll
    for (int i = 0; i < 8; ++i) {
      f32x2 t = {s[2 * i], s[2 * i + 1]};
      t = t * sc2 - cs2;
      t.x = __builtin_amdgcn_exp2f(t.x); t.y = __builtin_amdgcn_exp2f(t.y);
      if (CAUSAL) {
        if (kt * 32 + crow(2 * i, hh) > qpos) t.x = 0.f;
        if (kt * 32 + crow(2 * i + 1, hh) > qpos) t.y = 0.f;
      }
      l2 += t;
      pk[i] = pk2(t.x, t.y);
    }
    a.x = pk[0]; a.y = pk[1]; a.z = pk[2]; a.w = pk[3]; b.x = pk[4]; b.y = pk[5]; b.z = pk[6]; b.w = pk[7];
    const bf16x8 p0 = __builtin_bit_cast(bf16x8, a), p1 = __builtin_bit_cast(bf16x8, b);
#pragma unroll
    for (int dt = 0; dt < 4; ++dt) {
      const bf16x8 v0 = *(const LAS bf16x8*)(Vt + kt * 4096 + dt * 1024), v1 = *(const LAS bf16x8*)(Vt + kt * 4096 + dt * 1024 + 512);
      o[dt] = mfma32(v0, p0, o[dt]); o[dt] = mfma32(v1, p1, o[dt]);
    }
  }
  lsum += l2.x + l2.y;
}
DI float kmax_norm(const float* kmax2_bh) {
  float m = 0.f;
#pragma unroll
  for (int k = 0; k < 32; ++k) m = fmaxf(m, kmax2_bh[k]);
  return sqrtf(m);
}
DI float qf_norm2(const bf16x8 (&qf)[8]) {
  float n2 = 0.f;
#pragma unroll
  for (int ks = 0; ks < 8; ++ks) {
    const u32x4 u = __builtin_bit_cast(u32x4, qf[ks]);
    n2 += bf_lo(u.x) * bf_lo(u.x) + bf_hi(u.x) * bf_hi(u.x) + bf_lo(u.y) * bf_lo(u.y) + bf_hi(u.y) * bf_hi(u.y)
        + bf_lo(u.z) * bf_lo(u.z) + bf_hi(u.z) * bf_hi(u.z) + bf_lo(u.w) * bf_lo(u.w) + bf_hi(u.w) * bf_hi(u.w);
  }
  n2 += __shfl_xor(n2, 32);
  return n2;
}
struct T3 { float v1, v2, v3; int i1, i2, i3; };
DI bool t3_better(float v, int b, float w, int j) { return v > w || (v == w && b < j); }
DI T3 top3_insert(T3 t, float v, int blk) {
  const bool g1 = t3_better(v, blk, t.v1, t.i1), g2 = t3_better(v, blk, t.v2, t.i2), g3 = t3_better(v, blk, t.v3, t.i3);
  T3 r;
  r.v3 = g2 ? t.v2 : (g3 ? v : t.v3); r.i3 = g2 ? t.i2 : (g3 ? blk : t.i3);
  r.v2 = g1 ? t.v1 : (g2 ? v : t.v2); r.i2 = g1 ? t.i1 : (g2 ? blk : t.i2);
  r.v1 = g1 ? v : t.v1;               r.i1 = g1 ? blk : t.i1;
  return r;
}

constexpr int MB_K = 0, MB_V = 65536, MB_PRE = 131072, MB_END = MB_PRE + 768 * 4;
DI void stage_kv_block(const int tid, const bf16_t* kblk, const bf16_t* vblk, LAS char* lds) {
  const u32x4* ksrc = (const u32x4*)kblk; const u32x4* vsrc = (const u32x4*)vblk;
  u32x4 kk[8];
#pragma unroll
  for (int i = 0; i < 8; ++i) kk[i] = ksrc[tid + 512 * i];
#pragma unroll
  for (int i = 0; i < 8; ++i) *(LAS u32x4*)(lds + MB_K + (tid + 512 * i) * 16) = kk[i];
  __builtin_amdgcn_sched_barrier(0);
#pragma unroll
  for (int i = 0; i < 8; ++i) kk[i] = vsrc[tid + 512 * i];
#pragma unroll
  for (int i = 0; i < 8; ++i) *(LAS u32x4*)(lds + MB_V + (tid + 512 * i) * 16) = kk[i];
  __builtin_amdgcn_sched_barrier(0);
}
constexpr int MA_CNT = 131072, MA_BASE = MA_CNT + 128, MA_LIST = MA_CNT + 256, MA_END = MA_LIST + 32 * 256 * 2;
DI void store_partial(bf16_t* po, const f32x16 (&o)[4], const int hh) {
#pragma unroll
  for (int dt = 0; dt < 4; ++dt)
#pragma unroll
    for (int i4 = 0; i4 < 4; i4 += 2) {
      f32x4 v, u;
      v[0] = o[dt][4 * i4 + 0]; v[1] = o[dt][4 * i4 + 1]; v[2] = o[dt][4 * i4 + 2]; v[3] = o[dt][4 * i4 + 3];
      u[0] = o[dt][4 * i4 + 4]; u[1] = o[dt][4 * i4 + 5]; u[2] = o[dt][4 * i4 + 6]; u[3] = o[dt][4 * i4 + 7];
      *(u32x4*)(po + dt * 32 + 8 * i4 + 8 * hh) = widen32_pair(pk4(v), pk4(u));
    }
}
DI float* pl_ptr(char* ws, size_t bhq, int slot) { return (float*)(ws + OFF_PL4) + bhq * 4 + slot; }
DI bf16_t* po_slot(char* ws, int slot) { return (bf16_t*)(ws + (slot < 2 ? OFF_PO01 : OFF_PO2)) + (slot < 2 ? (size_t)slot * 24 * SEQ * 128 : 0); }

DI void moba_a_item(const int tid_, const Params& p, LAS char* lds, int item) {
  char* ws = p.ws;
  const int tid = launder(tid_);
  const int w = tid >> 6, lane = tid & 63, r = lane & 31, hh = lane >> 5;
  const int ob = item & 31, bh = item >> 5, h = bh % 6, b = bh / 6;
  LAS int* cnt = (LAS int*)(lds + MA_CNT);
  LAS int* gbase = (LAS int*)(lds + MA_BASE);
  LAS unsigned short* lists = (LAS unsigned short*)(lds + MA_LIST);
  const bf16_t* Q = (const bf16_t*)(ws + OFF_Q);
  const int tokbase = b * SEQ + ob * 256;
  __syncthreads();
  if (tid < 32) cnt[tid] = 0;
  __syncthreads();
  bf16x8 qf[8];
  {
    const bf16_t* qrow = Q + (size_t)(tokbase + 32 * w + r) * AW + h * 128 + 8 * hh;
#pragma unroll
    for (int ks = 0; ks < 8; ++ks) qf[ks] = *(const bf16x8*)(qrow + 16 * ks);
  }
  const float kmaxn = kmax_norm((const float*)(ws + OFF_KMAX2) + bh * 32);
  const float cs_own = sqrtf(qf_norm2(qf)) * kmaxn * ATT_SC;
  if (ob > 0) {
    f32x16 sc;
#pragma unroll
    for (int i = 0; i < 16; ++i) sc[i] = 0.f;
    const bf16_t* kmh = (const bf16_t*)(ws + OFF_KMEAN) + (size_t)bh * 4096 + lane * 8;
#pragma unroll
    for (int ks = 0; ks < 8; ++ks) {
      sc = mfma32(*(const bf16x8*)(kmh + ks * 512), qf[ks], sc);
      sc = mfma32(*(const bf16x8*)(kmh + 98304 + ks * 512), qf[ks], sc);
    }
    T3 t; t.v1 = t.v2 = t.v3 = -INFINITY; t.i1 = t.i2 = t.i3 = 999;
#pragma unroll
    for (int i = 0; i < 16; ++i) { const int blk = crow(i, hh); const bool ok = blk < ob; t = top3_insert(t, ok ? sc[i] : -INFINITY, ok ? blk : 1000); }
    T3 q;
    q.v1 = __shfl_xor(t.v1, 32); q.v2 = __shfl_xor(t.v2, 32); q.v3 = __shfl_xor(t.v3, 32);
    q.i1 = __shfl_xor(t.i1, 32); q.i2 = __shfl_xor(t.i2, 32); q.i3 = __shfl_xor(t.i3, 32);
    t = top3_insert(t, q.v1, q.i1); t = top3_insert(t, q.v2, q.i2); t = top3_insert(t, q.v3, q.i3);
    if (hh == 0) {
      const unsigned qa = (unsigned)(ob * 256 + 32 * w + r) << 2;
      if (t.i1 < 32) { const int sl = atomicAdd((int*)(cnt + t.i1), 1); lists[t.i1 * 256 + sl] = (unsigned short)(qa | 0u); }
      if (t.i2 < 32) { const int sl = atomicAdd((int*)(cnt + t.i2), 1); lists[t.i2 * 256 + sl] = (unsigned short)(qa | 1u); }
      if (t.i3 < 32) { const int sl = atomicAdd((int*)(cnt + t.i3), 1); lists[t.i3 * 256 + sl] = (unsigned short)(qa | 2u); }
    }
  }
  __syncthreads();
  if (tid < ob) { const int n = cnt[tid]; gbase[tid] = n ? (int)atomicAdd((unsigned*)(ws + OFF_GCNT) + bh * 32 + tid, (unsigned)n) : 0; }
  __syncthreads();
  {
    unsigned short* gl = (unsigned short*)(ws + OFF_GLIST) + (size_t)bh * 32 * SEQ;
#pragma unroll
    for (int k = 0; k < 4; ++k) {
      const int j = w * 4 + k;
      if (j < ob) {
        const int n = cnt[j], gb0 = gbase[j];
        for (int i = lane; i < n; i += 64) gl[(size_t)j * SEQ + gb0 + i] = lists[j * 256 + i];
      }
    }
  }
  {
    f32x16 o[4]; float ls = 0.f;
#pragma unroll
    for (int dt = 0; dt < 4; ++dt)
#pragma unroll
      for (int i = 0; i < 16; ++i) o[dt][i] = 0.f;
    const size_t boff = ((size_t)bh * 256 + ob * 8) * 4096;
    stage_kv_block(tid, (const bf16_t*)(ws + OFF_K) + boff, (const bf16_t*)(ws + OFF_VT) + boff, lds);
    __syncthreads();
    attn_unit_lds<true>(qf, (const LAS bf16_t*)(lds + MB_K) + lane * 8, (const LAS bf16_t*)(lds + MB_V) + lane * 8, w + 1, cs_own, 32 * w + r, hh, o, ls);
    ls += __shfl_xor(ls, 32);
    store_partial((bf16_t*)((char*)p.out + DO_OA) + (size_t)(tokbase + 32 * w + r) * AW + h * 128, o, hh);
    if (hh == 0) *pl_ptr(ws, (size_t)bh * SEQ + ob * 256 + 32 * w + r, 3) = ls;
  }
}

static_assert(MB_END <= LDS_BYTES && MA_END <= LDS_BYTES, "lds");
DI void phase3b(const Params& p, LAS char* lds, const int wv) {
  char* ws = p.ws;
  const int tid0 = make_tid(wv);
  LAS int* pre = (LAS int*)(lds + MB_PRE);
  const unsigned* gcnt = (const unsigned*)(ws + OFF_GCNT);
  __syncthreads();
  {
    const int tid = tid0, w = tid >> 6, lane = tid & 63;
    int c0 = 0, c1 = 0;
    if (tid < 384) { c0 = ((int)gcnt[2 * tid] + 255) >> 8; c1 = ((int)gcnt[2 * tid + 1] + 255) >> 8; }
    int incl = c0 + c1;
#pragma unroll
    for (int d = 1; d < 64; d <<= 1) { const int t = __shfl_up(incl, d); if (lane >= d) incl += t; }
    LAS int* wsum = pre + 768 - 8;
    __syncthreads();
    if (lane == 63) wsum[w] = incl;
    __syncthreads();
    int woff = 0;
    for (int k = 0; k < w; ++k) woff += wsum[k];
    __syncthreads();
    if (tid < 384) { pre[2 * tid] = woff + incl - c1; pre[2 * tid + 1] = woff + incl; }
    __syncthreads();
  }
  const int total = __builtin_amdgcn_readfirstlane(pre[767]);
  const float* kmax2 = (const float*)(ws + OFF_KMAX2);
  const int vblk = ((gridDim.x & 7) == 0) ? (int)((blockIdx.x & 7) * (gridDim.x >> 3) + (blockIdx.x >> 3)) : (int)blockIdx.x;
  const int u_lo = (int)(((long long)vblk * total) / (int)gridDim.x), u_hi = (int)(((long long)(vblk + 1) * total) / (int)gridDim.x);
  int prev_pair = -1;
  for (int u = u_lo; u < u_hi; ++u) {
    const int tid = launder(tid0), w = tid >> 6, lane = tid & 63, r = lane & 31, hh = lane >> 5;
    int lo = 0, hi = 767;
    while (lo < hi) { const int mid = (lo + hi) >> 1; if (pre[mid] > u) hi = mid; else lo = mid + 1; }
    const int pair = __builtin_amdgcn_readfirstlane(lo), bh = pair >> 5, j = pair & 31, h = bh % 6, b = bh / 6;
    const int chunk = __builtin_amdgcn_readfirstlane(u - (pair ? pre[pair - 1] : 0));
    const int n = __builtin_amdgcn_readfirstlane((int)gcnt[pair]);
    if (pair != prev_pair) {
      __syncthreads();
      stage_kv_block(tid, (const bf16_t*)(ws + OFF_K) + ((size_t)bh * 256 + j * 8) * 4096, (const bf16_t*)(ws + OFF_VT) + ((size_t)bh * 256 + j * 8) * 4096, lds);
      __syncthreads();
      prev_pair = pair;
    }
    const int idx = (chunk * 8 + w) * 32 + r;
    if ((chunk * 8 + w) * 32 < n) {
      const unsigned short* gl = (const unsigned short*)(ws + OFF_GLIST) + ((size_t)bh * 32 + j) * SEQ;
      const bool valid = idx < n;
      const unsigned e = gl[valid ? idx : n - 1];
      const int qa = (int)(e >> 2), slot = (int)(e & 3u);
      bf16x8 qf[8];
      {
        const bf16_t* qrow = (const bf16_t*)(ws + OFF_Q) + (size_t)(b * SEQ + qa) * AW + h * 128 + 8 * hh;
#pragma unroll
        for (int ks = 0; ks < 8; ++ks) qf[ks] = *(const bf16x8*)(qrow + 16 * ks);
      }
      const float kmaxn = kmax_norm(kmax2 + bh * 32);
      const float cs = sqrtf(qf_norm2(qf)) * kmaxn * ATT_SC;
      f32x16 o[4]; float ls = 0.f;
#pragma unroll
      for (int dt = 0; dt < 4; ++dt)
#pragma unroll
        for (int i = 0; i < 16; ++i) o[dt][i] = 0.f;
      attn_unit_lds<false>(qf, (const LAS bf16_t*)(lds + MB_K) + lane * 8, (const LAS bf16_t*)(lds + MB_V) + lane * 8, 8, cs, 1 << 30, hh, o, ls);
      ls += __shfl_xor(ls, 32);
      if (valid) {
        store_partial(po_slot(ws, slot) + ((size_t)bh * SEQ + qa) * 128, o, hh);
        if (hh == 0) *pl_ptr(ws, (size_t)bh * SEQ + qa, slot) = ls;
      }
    }
  }
  __syncthreads();
}

DI void phase3c(const Params& p, const int wv) {
  char* ws = p.ws;
  const size_t gt = (size_t)blockIdx.x * NTHREADS + make_tid(wv), NGT = (size_t)gridDim.x * NTHREADS;
  bf16_t* OA = (bf16_t*)((char*)p.out + DO_OA);
  const bf16_t* GA = (const bf16_t*)(ws + OFF_GA);
  const bf16_t* P0 = po_slot(ws, 0); const bf16_t* P1 = po_slot(ws, 1); const bf16_t* P2 = po_slot(ws, 2);
  const f32x4* L4 = (const f32x4*)(ws + OFF_PL4);
  const size_t N = (size_t)MTOK * 6 * 16;
  for (size_t base = gt; base < N; base += NGT * 4) {
    u32x4 vo[4], v0[4], v1[4], v2[4], vg[4]; f32x4 l4[4]; size_t oo[4]; int ns[4];
#pragma unroll
    for (int k = 0; k < 4; ++k) {
      const size_t i0 = base + k * NGT, i = i0 < N ? i0 : gt;
      const int c8 = (int)(i & 15), h = (int)((i >> 4) % 6), tok = (int)((i >> 4) / 6);
      const int b = tok >> 13, q = tok & (SEQ - 1), bh = b * 6 + h;
      ns[k] = min(q >> 8, 3);
      oo[k] = (size_t)tok * AW + h * 128 + c8 * 8;
      const size_t poff = ((size_t)bh * SEQ + q) * 128 + c8 * 8, loff = (size_t)bh * SEQ + q;
      vo[k] = *(const u32x4*)(OA + oo[k]); vg[k] = *(const u32x4*)(GA + oo[k]);
      v0[k] = *(const u32x4*)(P0 + poff); v1[k] = *(const u32x4*)(P1 + poff); v2[k] = *(const u32x4*)(P2 + poff);
      l4[k] = L4[loff];
    }
#pragma unroll
    for (int k = 0; k < 4; ++k) {
      if (base + k * NGT < N) {
        const bool s0 = ns[k] > 0, s1 = ns[k] > 1, s2 = ns[k] > 2;
        const u32x4 a = vo[k], b0 = v0[k], b1 = v1[k], b2 = v2[k], g = vg[k];
        float acc[8] = {bf_lo(a.x), bf_hi(a.x), bf_lo(a.y), bf_hi(a.y), bf_lo(a.z), bf_hi(a.z), bf_lo(a.w), bf_hi(a.w)};
        const float f0[8] = {bf_lo(b0.x), bf_hi(b0.x), bf_lo(b0.y), bf_hi(b0.y), bf_lo(b0.z), bf_hi(b0.z), bf_lo(b0.w), bf_hi(b0.w)};
        const float f1[8] = {bf_lo(b1.x), bf_hi(b1.x), bf_lo(b1.y), bf_hi(b1.y), bf_lo(b1.z), bf_hi(b1.z), bf_lo(b1.w), bf_hi(b1.w)};
        const float f2[8] = {bf_lo(b2.x), bf_hi(b2.x), bf_lo(b2.y), bf_hi(b2.y), bf_lo(b2.z), bf_hi(b2.z), bf_lo(b2.w), bf_hi(b2.w)};
#pragma unroll
        for (int e = 0; e < 8; ++e) acc[e] += (s0 ? f0[e] : 0.f) + (s1 ? f1[e] : 0.f) + (s2 ? f2[e] : 0.f);
        const float l = l4[k][3] + (s0 ? l4[k][0] : 0.f) + (s1 ? l4[k][1] : 0.f) + (s2 ? l4[k][2] : 0.f);
        const float inv = __builtin_amdgcn_rcpf(l);
        u32x4 o;
        o.x = pk2(acc[0] * inv * bf_lo(g.x), acc[1] * inv * bf_hi(g.x)); o.y = pk2(acc[2] * inv * bf_lo(g.y), acc[3] * inv * bf_hi(g.y));
        o.z = pk2(acc[4] * inv * bf_lo(g.z), acc[5] * inv * bf_hi(g.z)); o.w = pk2(acc[6] * inv * bf_lo(g.w), acc[7] * inv * bf_hi(g.w));
        *(u32x4*)(OA + oo[k]) = o;
      }
    }
  }
}

DI void xattn_pair(const int tid_, const Params& p, LAS char* lds, int bhd, int qt0) {
  char* ws = p.ws;
  const int tid = launder(tid_);
  const int w = tid >> 6, lane = tid & 63, r = lane & 31, hh = lane >> 5;
  const int hd = bhd & 3, b = bhd >> 2;
  __syncthreads();
  stage_kv_block(tid, (const bf16_t*)(ws + OFF_MEMK) + (size_t)bhd * 8 * 4096, (const bf16_t*)(ws + OFF_MEMVT) + (size_t)bhd * 8 * 4096, lds);
  __syncthreads();
  const float kmaxn = sqrtf(((const float*)(ws + OFF_MKMAX2))[bhd]);
#pragma unroll 1
  for (int i = 0; i < 2; ++i) {
    const int tok = b * SEQ + (qt0 + i) * 256 + 32 * w + r;
    bf16x8 qf[8];
    {
      const bf16_t* qrow = (const bf16_t*)(ws + OFF_QC) + (size_t)tok * CW + hd * 128 + 8 * hh;
#pragma unroll
      for (int ks = 0; ks < 8; ++ks) qf[ks] = *(const bf16x8*)(qrow + 16 * ks);
    }
    const float cs = sqrtf(qf_norm2(qf)) * kmaxn * ATT_SC;
    f32x16 o[4]; float ls = 0.f;
#pragma unroll
    for (int dt = 0; dt < 4; ++dt)
#pragma unroll
      for (int k = 0; k < 16; ++k) o[dt][k] = 0.f;
    attn_unit_lds<false>(qf, (const LAS bf16_t*)(lds + MB_K) + lane * 8, (const LAS bf16_t*)(lds + MB_V) + lane * 8, 8, cs, 1 << 30, hh, o, ls);
    ls += __shfl_xor(ls, 32);
    const float inv = __builtin_amdgcn_rcpf(ls);
    const bf16_t* gc = (const bf16_t*)(ws + OFF_GC) + (size_t)tok * CW + hd * 128 + 8 * hh;
    bf16_t* oc = (bf16_t*)((char*)p.out + DO_OC) + (size_t)tok * CW + hd * 128 + 8 * hh;
#pragma unroll
    for (int dt = 0; dt < 4; ++dt)
#pragma unroll
      for (int i4 = 0; i4 < 4; i4 += 2) {
        u32x2 ga, gb; unwiden32_pair(*(const u32x4*)(gc + dt * 32 + 8 * i4), ga, gb);
        f32x4 v, u;
        v[0] = o[dt][4 * i4 + 0] * inv * bf_lo(ga.x); v[1] = o[dt][4 * i4 + 1] * inv * bf_hi(ga.x);
        v[2] = o[dt][4 * i4 + 2] * inv * bf_lo(ga.y); v[3] = o[dt][4 * i4 + 3] * inv * bf_hi(ga.y);
        u[0] = o[dt][4 * i4 + 4] * inv * bf_lo(gb.x); u[1] = o[dt][4 * i4 + 5] * inv * bf_hi(gb.x);
        u[2] = o[dt][4 * i4 + 6] * inv * bf_lo(gb.y); u[3] = o[dt][4 * i4 + 7] * inv * bf_hi(gb.y);
        *(u32x4*)(oc + dt * 32 + 8 * i4) = widen32_pair(pk4(v), pk4(u));
      }
  }
}
DI void xattn_item(const int tid, const Params& p, int item) {
  char* ws = p.ws;
  const int w = tid >> 6, lane = tid & 63, r = lane & 31, hh = lane >> 5;
  const int qt = item & 31, bhd = item >> 5, hd = bhd & 3, b = bhd >> 2;
  const int tok = b * SEQ + qt * 256 + 32 * w + r;
  bf16x8 qf[8];
  {
    const bf16_t* qrow = (const bf16_t*)(ws + OFF_QC) + (size_t)tok * CW + hd * 128 + 8 * hh;
#pragma unroll
    for (int ks = 0; ks < 8; ++ks) qf[ks] = *(const bf16x8*)(qrow + 16 * ks);
  }
  const float kmaxn = sqrtf(((const float*)(ws + OFF_MKMAX2))[b * 4 + hd]);
  const float cs = sqrtf(qf_norm2(qf)) * kmaxn * ATT_SC;
  f32x16 o[4]; float ls = 0.f;
#pragma unroll
  for (int dt = 0; dt < 4; ++dt)
#pragma unroll
    for (int i = 0; i < 16; ++i) o[dt][i] = 0.f;
  const size_t boff = (size_t)bhd * 8 * 4096 + lane * 8;
  attn_unit(qf, (const bf16_t*)(ws + OFF_MEMK) + boff, (const bf16_t*)(ws + OFF_MEMVT) + boff, 8, cs, 1 << 30, hh, o, ls);
  ls += __shfl_xor(ls, 32);
  const float inv = 1.f / ls;
  const bf16_t* gc = (const bf16_t*)(ws + OFF_GC) + (size_t)tok * CW + hd * 128 + 4 * hh;
  bf16_t* oc = (bf16_t*)((char*)p.out + DO_OC) + (size_t)tok * CW + hd * 128 + 4 * hh;
#pragma unroll
  for (int dt = 0; dt < 4; ++dt)
#pragma unroll
    for (int i4 = 0; i4 < 4; ++i4) {
      const u32x2 g = *(const u32x2*)(gc + dt * 32 + 8 * i4);
      f32x4 v;
      v[0] = o[dt][4 * i4 + 0] * inv * bf_lo(g.x); v[1] = o[dt][4 * i4 + 1] * inv * bf_hi(g.x);
      v[2] = o[dt][4 * i4 + 2] * inv * bf_lo(g.y); v[3] = o[dt][4 * i4 + 3] * inv * bf_hi(g.y);
      st4(oc + dt * 32 + 8 * i4, v);
    }
}

DI void phase3a(const Params& p, LAS char* lds, const int wv) {
  const int tid = make_tid(wv);
  if (gridDim.x == 256) {
    const int xcd = blockIdx.x & 7, slot = blockIdx.x >> 3;
    for (int i = 0; i < 3; ++i) {
      const int bh = i * 8 + xcd;
      const int ob = (i == 0) ? slot : (i == 1 ? 31 - slot : ((slot + 16) & 31));
      moba_a_item(tid, p, lds, bh * 32 + ob);
    }
    xattn_pair(tid, p, lds, blockIdx.x >> 4, (blockIdx.x & 15) * 2);
  } else {
    for (int it = blockIdx.x; it < 768 + 512; it += gridDim.x) {
      if (it < 768) moba_a_item(tid, p, lds, it);
      else xattn_item(tid, p, it - 768);
    }
  }
}

DI void tile45(int L, int& tt, int& ct) {
  const int G = gridDim.x, b = blockIdx.x;
  if (G == 256) { const int xcd = b & 7, slot = b >> 3; tt = xcd * 16 + 8 * L + (slot & 7); ct = slot >> 3; }
  else { const int t = L * G + b; tt = t >> 2; ct = t & 3; }
}
struct P4Ops { const bf16_t *A, *B; int ld, K; };
DI P4Ops p4_ops(const Params& p, int tok0, int col0, int s) {
  char* ws = p.ws; P4Ops o;
  if (s == 0) { o.A = (const bf16_t*)(ws + OFF_WA) + (size_t)col0 * AW; o.B = (const bf16_t*)((const char*)p.out + DO_OA) + (size_t)tok0 * AW; o.ld = AW; o.K = AW; }
  else if (s == 1) { o.A = (const bf16_t*)(ws + OFF_WB) + (size_t)col0 * AW; o.B = (const bf16_t*)((const char*)p.out + DO_OB) + (size_t)tok0 * AW; o.ld = AW; o.K = AW; }
  else if (s == 2) { o.A = (const bf16_t*)(ws + OFF_WC) + (size_t)col0 * CW; o.B = (const bf16_t*)((const char*)p.out + DO_OC) + (size_t)tok0 * CW; o.ld = CW; o.K = CW; }
  else { o.A = (const bf16_t*)(ws + OFF_WIN) + (size_t)(6400 + (s - 3) * 1024 + col0) * DM; o.B = (const bf16_t*)(ws + OFF_HB) + (size_t)tok0 * DM; o.ld = DM; o.K = DM; }
  return o;
}
DI void phase4(const Params& p, LAS char* lds, const int wv) {
  char* ws = p.ws;
  const int tid = make_tid(wv);
  const int nL = (gridDim.x == 256) ? 2 : (512 + gridDim.x - 1) / gridDim.x;
  int nvalid = 0;
  for (int L = 0; L < nL; ++L) { int tt, ct; tile45(L, tt, ct); if (tt < 128) nvalid = L + 1; }
  if (nvalid == 0) return;
  { int tt, ct; tile45(0, tt, ct); const P4Ops o = p4_ops(p, tt * 256, ct * 256, 0); gemm_begin(tid, o.A, o.B, o.ld, lds); }
#pragma unroll 1
  for (int u = 0; u < nvalid * 6; ++u) {
    const int L = u / 6, s = u - L * 6;
    int tt, ct; tile45(L, tt, ct);
    const int tok0 = tt * 256, col0 = ct * 256;
    const P4Ops o = p4_ops(p, tok0, col0, s);
    const int un = (u + 1 < nvalid * 6) ? u + 1 : u, Ln = un / 6, sn = un - Ln * 6;
    int t2, c2; tile45(Ln, t2, c2);
    const P4Ops nx = p4_ops(p, t2 * 256, c2 * 256, sn);
    f32x4 acc[2][2][4][2];
    gemm_unit(tid, o.A, o.B, o.ld, o.K, nx.A, nx.B, nx.ld, lds, acc);
    if (s < 3) epi_rowmajor(tid, acc, (bf16_t*)(ws + (s == 0 ? OFF_TA : (s == 1 ? OFF_TB : OFF_TC))), DM, tok0, col0, EP_PLAIN, nullptr);
    else epi_gate(tid, acc, (const bf16_t*)(ws + (s == 3 ? OFF_TA : (s == 4 ? OFF_TB : OFF_TC))), (bf16_t*)(ws + OFF_Y), tok0, col0, s == 3);
  }
  gemm_end(tid);
}
DI void phase5(const Params& p, LAS char* lds, const int wv, float* rowss) {
  char* ws = p.ws;
  const int tid = make_tid(wv);
  const int nL = (gridDim.x == 256) ? 2 : (512 + gridDim.x - 1) / gridDim.x;
  int nvalid = 0;
  for (int L = 0; L < nL; ++L) { int tt, ct; tile45(L, tt, ct); if (tt < 128) nvalid = L + 1; }
  if (nvalid == 0) return;
  const bf16_t* WO = (const bf16_t*)(ws + OFF_WO); const bf16_t* Y = (const bf16_t*)(ws + OFF_Y);
  if (tid == 0) *(LAS unsigned*)(lds + 131072 + 8192) = 0u;
  { int tt, ct; tile45(0, tt, ct); gemm_begin(tid, WO + (size_t)ct * 256 * DM, Y + (size_t)tt * 256 * DM, DM, lds); }
#pragma unroll 1
  for (int L = 0; L < nvalid; ++L) {
    int tt, ct; tile45(L, tt, ct);
    int t2, c2; tile45((L + 1 < nvalid) ? L + 1 : L, t2, c2);
    f32x4 acc[2][2][4][2];
    gemm_unit(tid, WO + (size_t)ct * 256 * DM, Y + (size_t)tt * 256 * DM, DM, DM, WO + (size_t)c2 * 256 * DM, Y + (size_t)t2 * 256 * DM, DM, lds, acc);
    const int wr5 = __builtin_amdgcn_readfirstlane(tid >> 8);
    if (wr5 == 0) G_BAR;
    epi_out_norm(tid, acc, p.x, p.out, rowss, (unsigned*)(ws + OFF_C5) + tt, p.final_g, tt * 256, ct * 256, (LAS unsigned*)(lds + 131072 + 8192));
    if (wr5 == 1) G_BAR;
  }
  gemm_end(tid);
}
DI void phase6(const Params& p, const int wv) {
  const size_t gt = (size_t)blockIdx.x * NTHREADS + make_tid(wv), NGT = (size_t)gridDim.x * NTHREADS;
  const float* rowss = (const float*)(p.ws + OFF_ROWSS);
  const size_t N = (size_t)MTOK * (DM / 4);
  f32x4* out4 = (f32x4*)p.out;
  for (size_t base = gt; base < N; base += NGT * 8) {
    f32x4 z[8]; float ss[8];
#pragma unroll
    for (int k = 0; k < 8; ++k) { const size_t i = base + k * NGT; const size_t ic = i < N ? i : gt; z[k] = out4[ic]; ss[k] = rowss[ic >> 8]; }
#pragma unroll
    for (int k = 0; k < 8; ++k) {
      const size_t i = base + k * NGT;
      if (i < N) {
        const float rs = rsqrtf(ss[k] * (1.f / DM) + 1e-6f);
        const f32x4 g = ((const f32x4*)p.final_g)[i & 255];
        f32x4 o; o[0] = z[k][0] * rs * g[0]; o[1] = z[k][1] * rs * g[1]; o[2] = z[k][2] * rs * g[2]; o[3] = z[k][3] * rs * g[3];
        out4[i] = o;
      }
    }
  }
}

__global__ void __launch_bounds__(NTHREADS) fwd_megakernel(Params p) {
  extern __shared__ __attribute__((aligned(16))) char smem_raw[];
  LAS char* lds = (LAS char*)smem_raw;
  cg::grid_group grid = cg::this_grid();
  const int wv = __builtin_amdgcn_readfirstlane((int)threadIdx.x >> 6);
  for (int rep = 0; rep < REP0; ++rep) phase0(p, lds, wv);
  grid.sync();
  unsigned* bar = (unsigned*)(p.ws + OFF_BAR);
  const unsigned G = gridDim.x;
  for (int rep = 0; rep < REP1; ++rep) phase1(p, lds, wv);
  grid_bar(bar, 1u, make_tid(wv));
  for (int rep = 0; rep < REP2; ++rep) phase2(p, lds, wv);
  grid_bar(bar, 2u, make_tid(wv));
  phase3a(p, lds, wv);
  grid_bar(bar, 3u, make_tid(wv));
  for (int rep = 0; rep < REP3; ++rep) phase3b(p, lds, wv);
  grid_bar(bar, 4u, make_tid(wv));
  phase3c(p, wv);
  grid_bar(bar, 5u, make_tid(wv));
  for (int rep = 0; rep < REP4; ++rep) phase4(p, lds, wv);
  grid_bar(bar, 6u, make_tid(wv));
  phase5(p, lds, wv, (float*)(p.ws + OFF_ROWSS));
}

extern "C" void kernel_launch(void* const* d_in, const int* in_sizes, int n_in,
                              void* d_out, int out_size, void* d_ws, size_t ws_size,
                              hipStream_t stream) {
  static int grid_blocks = 0;
  if (!grid_blocks) {
    int dev = 0, cus = 0, per_cu = 0;
    (void)hipGetDevice(&dev);
    (void)hipDeviceGetAttribute(&cus, hipDeviceAttributeMultiprocessorCount, dev);
    (void)hipFuncSetAttribute((const void*)fwd_megakernel, hipFuncAttributeMaxDynamicSharedMemorySize, LDS_BYTES);
    (void)hipOccupancyMaxActiveBlocksPerMultiprocessor(&per_cu, (const void*)fwd_megakernel, NTHREADS, LDS_BYTES);
    if (per_cu < 1) per_cu = 1;
    grid_blocks = cus * per_cu;
    if (ws_size < WS_END3) fprintf(stderr, "kernel_launch: workspace too small: %zu < %zu\n", ws_size, (size_t)WS_END3);
  }
  Params p{};
  p.x = (const float*)d_in[0]; p.mem = (const float*)d_in[1]; p.norm_g = (const float*)d_in[2]; p.mem_norm_g = (const float*)d_in[3];
  p.final_g = (const float*)d_in[4]; p.w_in = (const float*)d_in[5]; p.w_mkv = (const float*)d_in[6]; p.ln_g = (const float*)d_in[7];
  p.w_sp = (const float*)d_in[8]; p.b_sp = (const float*)d_in[9]; p.w_a = (const float*)d_in[10]; p.w_b = (const float*)d_in[11];
  p.w_c = (const float*)d_in[12]; p.w_out = (const float*)d_in[13];
  p.out = (float*)d_out; p.ws = (char*)d_ws;
  void* args[] = {&p};
  hipError_t e = hipLaunchCooperativeKernel((void*)fwd_megakernel, dim3(grid_blocks), dim3(NTHREADS), args, LDS_BYTES, stream);
  if (e != hipSuccess) fprintf(stderr, "cooperative launch failed: %s (grid %d)\n", hipGetErrorString(e), grid_blocks);
}
```

```cpp
#include <hip/hip_runtime.h>
#include <hip/hip_cooperative_groups.h>
#include <cstdio>
#include <cstdint>
namespace cg = cooperative_groups;

#define LAS __attribute__((address_space(3)))
#define DI __device__ __forceinline__

typedef unsigned short bf16_t;
typedef short bf16x8 __attribute__((ext_vector_type(8)));
typedef float f32x2 __attribute__((ext_vector_type(2)));
typedef float f32x4 __attribute__((ext_vector_type(4)));
typedef float f32x16 __attribute__((ext_vector_type(16)));
typedef __bf16 bf16x2_t __attribute__((ext_vector_type(2)));
typedef unsigned u32x2 __attribute__((ext_vector_type(2)));
typedef unsigned u32x4 __attribute__((ext_vector_type(4)));

#define REP0 1
#define REP1 1
#define REP2 1
#define REP2G 1
#define REP3 1
#define REP4 1
#define REP5 1
constexpr int DM = 1024, NB = 4, SEQ = 8192, MTOK = NB * SEQ;
constexpr int AW = 768, CW = 512, INW = 9472;
constexpr int NTHREADS = 512;
constexpr int LDS_BYTES = 152 * 1024;

constexpr size_t MiB = 1u << 20;
constexpr size_t OFF_ROWSS = 0;
constexpr size_t OFF_KMEAN = 131072;
constexpr size_t OFF_KMAX2 = 524288;
constexpr size_t OFF_MKMAX2 = 528384;
constexpr size_t OFF_BAR = 528384 + 1024;
constexpr size_t OFF_GCNT = 528384 + 2048;
constexpr size_t OFF_C5 = 528384 + 2048 + 3072;
constexpr size_t OFF_WF = 540672;
constexpr size_t OFF_ROPE = 1 * MiB;
constexpr size_t OFF_HB = 2 * MiB;
constexpr size_t OFF_WIN = 66 * MiB;
constexpr size_t OFF_WMKV = OFF_WIN + (size_t)INW * 1024 * 2;
constexpr size_t OFF_WA = OFF_WMKV + 2 * MiB;
constexpr size_t OFF_WB = OFF_WA + 1536 * 1024;
constexpr size_t OFF_WC = OFF_WB + 1536 * 1024;
constexpr size_t OFF_WO = OFF_WC + 1 * MiB;
constexpr size_t OFF_MEMN = OFF_WO + 2 * MiB;
constexpr size_t OFF_MEMK = OFF_MEMN + 2 * MiB;
constexpr size_t OFF_MEMVT = OFF_MEMK + 1 * MiB;
constexpr size_t OFF_REG = 97 * MiB;
constexpr size_t OFF_Q = OFF_REG;
constexpr size_t OFF_K = OFF_REG + 48 * MiB;
constexpr size_t OFF_VT = OFF_REG + 96 * MiB;
constexpr size_t OFF_VBT = OFF_REG + 144 * MiB;
constexpr size_t OFF_GB = OFF_REG + 192 * MiB;
constexpr size_t OFF_QC = OFF_REG + 240 * MiB;
constexpr size_t OFF_GA = OFF_REG + 272 * MiB;
constexpr size_t OFF_UB = OFF_REG + 320 * MiB;
constexpr size_t OFF_GC = OFF_REG + 368 * MiB;
constexpr size_t WS_END = OFF_REG + 400 * MiB;
constexpr size_t OFF_GLIST = OFF_WIN;
constexpr size_t WS_END2 = WS_END;
static_assert(12 * MiB <= (size_t)6400 * 1024 * 2, "query lists must fit the dead part of the input-projection weights");
constexpr size_t OFF_PO01 = OFF_VBT, OFF_PO2 = OFF_UB;
constexpr size_t OFF_PL01 = OFF_WMKV, OFF_PL23 = OFF_MEMN;
constexpr size_t OFF_PL4 = WS_END2; constexpr size_t WS_END3 = WS_END2 + 3 * MiB;
constexpr size_t OFF_TA = OFF_REG;
constexpr size_t OFF_TB = OFF_REG + 64 * MiB;
constexpr size_t OFF_TC = OFF_REG + 128 * MiB;
constexpr size_t OFF_Y = OFF_REG + 192 * MiB;
static_assert(OFF_MEMVT + 1 * MiB <= OFF_REG, "ws map");
constexpr size_t DO_OA = 0, DO_OC = 48 * MiB, DO_OB = 80 * MiB;

struct Params {
  const float *x, *mem, *norm_g, *mem_norm_g, *final_g, *w_in, *w_mkv, *ln_g, *w_sp, *b_sp, *w_a, *w_b, *w_c, *w_out;
  float* out; char* ws;
};

DI unsigned pk2(float lo, float hi) { f32x2 v = {lo, hi}; return __builtin_bit_cast(unsigned, __builtin_convertvector(v, bf16x2_t)); }
DI float bf_lo(unsigned u) { return __uint_as_float(u << 16); }
DI float bf_hi(unsigned u) { return __uint_as_float(u & 0xffff0000u); }
DI float wave_sum(float v) {
#pragma unroll
  for (int o = 1; o < 64; o <<= 1) v += __shfl_xor(v, o);
  return v;
}
DI float wave_max(float v) {
#pragma unroll
  for (int o = 1; o < 64; o <<= 1) v = fmaxf(v, __shfl_xor(v, o));
  return v;
}
DI float silu_f(float v) { return v * __builtin_amdgcn_rcpf(1.f + __expf(-v)); }
DI float sigmoid_f(float v) { return __builtin_amdgcn_rcpf(1.f + __expf(-v)); }
DI f32x16 mfma32(bf16x8 a, bf16x8 b, f32x16 c) { return __builtin_amdgcn_mfma_f32_32x32x16_bf16(a, b, c, 0, 0, 0); }
DI int crow(int i, int hh) { return (i & 3) + 8 * (i >> 2) + 4 * hh; }
DI int launder(int v) { asm volatile("" : "+v"(v)); return v; }
DI int make_tid(const int wv) { int l; asm volatile("v_mbcnt_lo_u32_b32 %0, -1, 0\n\tv_mbcnt_hi_u32_b32 %0, -1, %0" : "=v"(l)); return wv * 64 + l; }
DI void lds_wait() { asm volatile("s_waitcnt lgkmcnt(0)" ::: "memory"); }

DI void grid_bar(unsigned* ctr, unsigned k, const int tid) {
  __syncthreads();
  if (tid == 0) {
    const unsigned g = blockIdx.x & 7u, gsz = (gridDim.x - g + 7u) >> 3, ngrp = gridDim.x < 8u ? gridDim.x : 8u;
    __builtin_amdgcn_fence(__ATOMIC_RELEASE, "agent");
    const unsigned old = __hip_atomic_fetch_add(ctr + 16 + 16 * g, 1u, __ATOMIC_RELAXED, __HIP_MEMORY_SCOPE_AGENT);
    if (old + 1u == gsz * k) __hip_atomic_fetch_add(ctr, 1u, __ATOMIC_RELAXED, __HIP_MEMORY_SCOPE_AGENT);
    while (__hip_atomic_load(ctr, __ATOMIC_RELAXED, __HIP_MEMORY_SCOPE_AGENT) < ngrp * k) __builtin_amdgcn_s_sleep(2);
    __builtin_amdgcn_fence(__ATOMIC_ACQUIRE, "agent");
  }
  __syncthreads();
}

constexpr int BK = 64, HALF = 128, HTB = HALF * BK * 2;
DI int lds_byte(int r, int c) { int st = (r >> 4) * 2 + (c >> 5), rr = r & 15, cc = c & 31, ob = rr * 64 + cc * 2; return st * 1024 + (ob ^ (((ob >> 9) & 1) << 5)); }
DI void stage_rc(int b, int& R, int& C) { int st = b / 1024, sb = b % 1024, swz = sb ^ (((sb >> 9) & 1) << 5); R = (st >> 1) * 16 + swz / 64; C = (st & 1) * 32 + (swz % 64) / 2; }

DI void gemm_tile(const int tid, const bf16_t* A, const bf16_t* Bm, const int ld, int K, LAS char* lds, f32x4 (&acc)[2][2][4][2]) {
  const int wid = __builtin_amdgcn_readfirstlane(tid >> 6), lane = tid & 63, wr = wid >> 2, wc = wid & 3, fr = lane & 15, fq = lane >> 4;
  unsigned voffA[2];
#pragma unroll
  for (int i = 0; i < 2; ++i) { int R, C; stage_rc(tid * 16 + i * 8192, R, C); voffA[i] = (unsigned)(R * ld + C) * 2u; }
#define voffB voffA
  const unsigned ldsw = (unsigned)wid * 1024u;
  const int aoff = lds_byte(wr * 64 + fr, fq * 8), boff = lds_byte(wc * 32 + fr, fq * 8);
  const char* cA0 = (const char*)A; const char* cA1 = cA0 + (size_t)HALF * ld * 2;
  const char* cB0 = (const char*)Bm; const char* cB1 = cB0 + (size_t)HALF * ld * 2;
#define G_SA(b, h) (((b) * 2 + (h)) * HTB)
#define G_SB(b, h) ((4 + (b) * 2 + (h)) * HTB)
#define G_STAGE(bufoff, gbase, voff, kt) do { _Pragma("unroll") for (int _i = 0; _i < 2; ++_i) \
    __builtin_amdgcn_global_load_lds((const unsigned*)((gbase) + (size_t)(kt) * (BK * 2) + (voff)[_i]), (LAS unsigned*)(lds + (bufoff) + ldsw + _i * 8192), 16, 0, 0); } while (0)
#define G_LDA(dst, b, h) do { _Pragma("unroll") for (int m = 0; m < 4; ++m) _Pragma("unroll") for (int k = 0; k < 2; ++k) dst[m][k] = *(const LAS bf16x8*)(lds + G_SA(b, h) + aoff + m * 2048 + k * 1024); } while (0)
#define G_LDB(dst, b, h) do { _Pragma("unroll") for (int n = 0; n < 2; ++n) _Pragma("unroll") for (int k = 0; k < 2; ++k) dst[n][k] = *(const LAS bf16x8*)(lds + G_SB(b, h) + boff + n * 2048 + k * 1024); } while (0)
#define G_MMA(ai, bj, At, Bt) do { __builtin_amdgcn_s_setprio(1); _Pragma("unroll") for (int m = 0; m < 4; ++m) _Pragma("unroll") for (int n = 0; n < 2; ++n) _Pragma("unroll") for (int k = 0; k < 2; ++k) \
    acc[ai][bj][m][n] = __builtin_amdgcn_mfma_f32_16x16x32_bf16(At[m][k], Bt[n][k], acc[ai][bj][m][n], 0, 0, 0); __builtin_amdgcn_s_setprio(0); } while (0)
#define G_WAIT_V(n) asm volatile("s_waitcnt vmcnt(" #n ")" ::: "memory")
#define G_WAIT_L(n) asm volatile("s_waitcnt lgkmcnt(" #n ")" ::: "memory")
#define G_BAR __builtin_amdgcn_s_barrier()
#define G_SCHED __builtin_amdgcn_sched_barrier(0)
#pragma unroll
  for (int a = 0; a < 2; ++a)
#pragma unroll
    for (int b = 0; b < 2; ++b)
#pragma unroll
      for (int m = 0; m < 4; ++m)
#pragma unroll
        for (int n = 0; n < 2; ++n) acc[a][b][m][n] = (f32x4){0.f, 0.f, 0.f, 0.f};
  bf16x8 At[4][2], B0[2][2], B1[2][2];
  const int nt = K / BK;
  G_WAIT_V(0); G_WAIT_L(0); __syncthreads();
  G_STAGE(G_SB(0, 0), cB0, voffB, 0); G_STAGE(G_SA(0, 0), cA0, voffA, 0);
  G_STAGE(G_SB(0, 1), cB1, voffB, 0); G_STAGE(G_SA(0, 1), cA1, voffA, 0);
  if (wr == 1) G_BAR;
  G_WAIT_V(4); G_BAR;
  G_STAGE(G_SB(1, 0), cB0, voffB, 1); G_STAGE(G_SA(1, 0), cA0, voffA, 1); G_STAGE(G_SB(1, 1), cB1, voffB, 1);
  G_WAIT_V(6); G_BAR;
  for (int t = 0; t < nt - 2; t += 2) {
    G_LDB(B0, 0, 0); G_SCHED; G_LDA(At, 0, 0); G_STAGE(G_SA(1, 1), cA1, voffA, t + 1);
    G_WAIT_L(8); G_BAR; G_WAIT_L(0); G_MMA(0, 0, At, B0); G_BAR; G_SCHED;
    G_LDB(B1, 0, 1); G_STAGE(G_SB(0, 0), cB0, voffB, t + 2);
    G_BAR; G_WAIT_L(0); G_MMA(0, 1, At, B1); G_BAR;
    G_LDA(At, 0, 1); G_STAGE(G_SA(0, 0), cA0, voffA, t + 2);
    G_BAR; G_WAIT_L(0); G_MMA(1, 0, At, B0); G_BAR; G_SCHED;
    G_STAGE(G_SB(0, 1), cB1, voffB, t + 2);
    G_WAIT_V(6); G_BAR; G_MMA(1, 1, At, B1); G_BAR;
    G_LDB(B0, 1, 0); G_SCHED; G_LDA(At, 1, 0); G_STAGE(G_SA(0, 1), cA1, voffA, t + 2);
    G_WAIT_L(8); G_BAR; G_WAIT_L(0); G_MMA(0, 0, At, B0); G_BAR; G_SCHED;
    G_LDB(B1, 1, 1); G_STAGE(G_SB(1, 0), cB0, voffB, t + 3);
    G_BAR; G_WAIT_L(0); G_MMA(0, 1, At, B1); G_BAR;
    G_LDA(At, 1, 1); G_STAGE(G_SA(1, 0), cA0, voffA, t + 3);
    G_BAR; G_WAIT_L(0); G_MMA(1, 0, At, B0); G_BAR; G_SCHED;
    G_STAGE(G_SB(1, 1), cB1, voffB, t + 3);
    G_WAIT_V(6); G_BAR; G_MMA(1, 1, At, B1); G_BAR;
  }
  { G_LDB(B0, 0, 0); G_LDA(At, 0, 0); G_STAGE(G_SA(1, 1), cA1, voffA, nt - 1);
    G_BAR; G_WAIT_L(0); G_MMA(0, 0, At, B0); G_BAR;
    G_LDB(B1, 0, 1); G_BAR; G_WAIT_L(0); G_MMA(0, 1, At, B1); G_BAR;
    G_LDA(At, 0, 1); G_WAIT_V(4); G_BAR; G_WAIT_L(0); G_MMA(1, 0, At, B0); G_MMA(1, 1, At, B1); G_BAR; }
  { G_LDB(B0, 1, 0); G_LDA(At, 1, 0); G_WAIT_V(2); G_BAR; G_WAIT_L(0); G_MMA(0, 0, At, B0); G_BAR;
    G_LDB(B1, 1, 1); G_WAIT_V(0); G_BAR; G_WAIT_L(0); G_MMA(0, 1, At, B1); G_BAR;
    G_LDA(At, 1, 1); G_BAR; G_WAIT_L(0); G_MMA(1, 0, At, B0); G_MMA(1, 1, At, B1); G_BAR; }
  if (wr == 0) G_BAR;
  asm volatile("" ::: "memory");
  G_SCHED;
}

struct GStream { unsigned voff[2]; };
DI void stage_offsets(const int tid, const int ld, unsigned (&voff)[2]) {
#pragma unroll
  for (int i = 0; i < 2; ++i) { int R, C; stage_rc(tid * 16 + i * 8192, R, C); voff[i] = (unsigned)(R * ld + C) * 2u; }
}
#define GS_STAGE(bufoff, gptr, vo) do { _Pragma("unroll") for (int _i = 0; _i < 2; ++_i) \
    __builtin_amdgcn_global_load_lds((const unsigned*)((gptr) + (vo)[_i]), (LAS unsigned*)(lds + (bufoff) + ldsw + _i * 8192), 16, 0, 0); } while (0)
DI void gemm_begin(const int tid, const bf16_t* A, const bf16_t* Bm, const int ld, LAS char* lds) {
  const int wid = __builtin_amdgcn_readfirstlane(tid >> 6), wr = wid >> 2;
  unsigned vo[2]; stage_offsets(tid, ld, vo);
  const unsigned ldsw = (unsigned)wid * 1024u;
  const char* cA = (const char*)A; const char* cB = (const char*)Bm;
  const size_t hstep = (size_t)HALF * ld * 2, kstep = BK * 2;
  __syncthreads();
  GS_STAGE(G_SB(0, 0), cB, vo); GS_STAGE(G_SB(0, 1), cB + hstep, vo); GS_STAGE(G_SA(0, 0), cA, vo); GS_STAGE(G_SA(0, 1), cA + hstep, vo);
  if (wr == 1) G_BAR;
  G_WAIT_V(2); G_BAR;
  GS_STAGE(G_SB(1, 0), cB + kstep, vo); GS_STAGE(G_SA(1, 0), cA + kstep, vo); GS_STAGE(G_SB(1, 1), cB + hstep + kstep, vo);
  G_WAIT_V(6); G_BAR;
}
DI void gemm_end(const int tid) {
  const int wr = __builtin_amdgcn_readfirstlane(tid >> 6) >> 2;
  G_WAIT_V(0);
  if (wr == 0) G_BAR;
  G_BAR;
}
DI void gemm_unit(const int tid, const bf16_t* A, const bf16_t* Bm, const int ld, const int K,
                  const bf16_t* An, const bf16_t* Bn, const int ldn, LAS char* lds, f32x4 (&acc)[2][2][4][2]) {
  const int wid = __builtin_amdgcn_readfirstlane(tid >> 6), lane = tid & 63, wr = wid >> 2, wc = wid & 3, fr = lane & 15, fq = lane >> 4;
  unsigned voC[2], voN[2]; stage_offsets(tid, ld, voC); stage_offsets(tid, ldn, voN);
  const unsigned ldsw = (unsigned)wid * 1024u;
  const int aoff = lds_byte(wr * 64 + fr, fq * 8), boff = lds_byte(wc * 32 + fr, fq * 8);
  const char* cA = (const char*)A; const char* cB = (const char*)Bm;
  const char* nA = (const char*)An; const char* nB = (const char*)Bn;
  const size_t hstepC = (size_t)HALF * ld * 2, hstepN = (size_t)HALF * ldn * 2, kstep = BK * 2;
#pragma unroll
  for (int a = 0; a < 2; ++a)
#pragma unroll
    for (int b = 0; b < 2; ++b)
#pragma unroll
      for (int m = 0; m < 4; ++m)
#pragma unroll
        for (int n = 0; n < 2; ++n) acc[a][b][m][n] = (f32x4){0.f, 0.f, 0.f, 0.f};
  bf16x8 At[4][2], B0[2][2], B1[2][2];
  const int nt = K / BK;
  for (int t = 0; t < nt; t += 2) {
    const bool last = (t == nt - 2);
    const char* a1 = cA + (size_t)(t + 1) * kstep;
    const char* a2 = last ? nA : cA + (size_t)(t + 2) * kstep; const char* b2 = last ? nB : cB + (size_t)(t + 2) * kstep;
    const char* a3 = a2 + kstep; const char* b3 = b2 + kstep;
    const size_t hs2 = last ? hstepN : hstepC;
    unsigned vo2[2]; vo2[0] = last ? voN[0] : voC[0]; vo2[1] = last ? voN[1] : voC[1];
    G_LDB(B0, 0, 0); G_LDB(B1, 0, 1); G_SCHED; G_LDA(At, 0, 0); GS_STAGE(G_SA(1, 1), a1 + hstepC, voC);
    G_WAIT_V(8); G_WAIT_L(0); G_BAR; G_MMA(0, 0, At, B0); G_MMA(0, 1, At, B1); G_BAR; G_SCHED;
    G_LDA(At, 0, 1); GS_STAGE(G_SB(0, 0), b2, vo2); GS_STAGE(G_SB(0, 1), b2 + hs2, vo2); GS_STAGE(G_SA(0, 0), a2, vo2);
    G_WAIT_V(8); G_WAIT_L(0); G_BAR; G_MMA(1, 0, At, B0); G_MMA(1, 1, At, B1); G_BAR; G_SCHED;
    G_LDB(B0, 1, 0); G_LDB(B1, 1, 1); G_SCHED; G_LDA(At, 1, 0); GS_STAGE(G_SA(0, 1), a2 + hs2, vo2);
    G_WAIT_V(8); G_WAIT_L(0); G_BAR; G_MMA(0, 0, At, B0); G_MMA(0, 1, At, B1); G_BAR; G_SCHED;
    G_LDA(At, 1, 1); GS_STAGE(G_SB(1, 0), b3, vo2); GS_STAGE(G_SB(1, 1), b3 + hs2, vo2); GS_STAGE(G_SA(1, 0), a3, vo2);
    G_WAIT_V(8); G_WAIT_L(0); G_BAR; G_MMA(1, 0, At, B0); G_MMA(1, 1, At, B1); G_BAR; G_SCHED;
  }
  asm volatile("" ::: "memory");
  G_SCHED;
}

struct Geo { int wr, wc, fr, fq; };
DI Geo geo(const int tid) { const int wid = tid >> 6, lane = tid & 63; Geo g; g.wr = wid >> 2; g.wc = wid & 3; g.fr = lane & 15; g.fq = lane >> 4; return g; }
DI void st4(bf16_t* p, f32x4 v) { u32x2 o; o.x = pk2(v[0], v[1]); o.y = pk2(v[2], v[3]); *(u32x2*)p = o; }

enum { EP_PLAIN = 0, EP_SILU = 1, EP_ROPE = 2, EP_KFRAG = 4 };
DI u32x4 widen_pair(const u32x2 a, const u32x2 b) {
  const auto r0 = __builtin_amdgcn_permlane16_swap(a.x, b.x, false, false);
  const auto r1 = __builtin_amdgcn_permlane16_swap(a.y, b.y, false, false);
  u32x4 o; o.x = r0[0]; o.y = r1[0]; o.z = r0[1]; o.w = r1[1]; return o;
}
DI void unwiden_pair(const u32x4 w, u32x2& a, u32x2& b) {
  const auto r0 = __builtin_amdgcn_permlane16_swap(w.x, w.z, false, false);
  const auto r1 = __builtin_amdgcn_permlane16_swap(w.y, w.w, false, false);
  a.x = r0[0]; a.y = r1[0]; b.x = r0[1]; b.y = r1[1];
}
DI u32x4 widen32_pair(const u32x2 a, const u32x2 b) {
  const auto r0 = __builtin_amdgcn_permlane32_swap(a.x, b.x, false, false);
  const auto r1 = __builtin_amdgcn_permlane32_swap(a.y, b.y, false, false);
  u32x4 o; o.x = r0[0]; o.y = r1[0]; o.z = r0[1]; o.w = r1[1]; return o;
}
DI void unwiden32_pair(const u32x4 w, u32x2& a, u32x2& b) {
  const auto r0 = __builtin_amdgcn_permlane32_swap(w.x, w.z, false, false);
  const auto r1 = __builtin_amdgcn_permlane32_swap(w.y, w.w, false, false);
  a.x = r0[0]; a.y = r1[0]; b.x = r0[1]; b.y = r1[1];
}
DI u32x2 pk4(const f32x4 v) { u32x2 o; o.x = pk2(v[0], v[1]); o.y = pk2(v[2], v[3]); return o; }
DI void epi_rowmajor(const int tid, f32x4 (&acc)[2][2][4][2], bf16_t* dst, int ld, int tok0, int col0, int mode, const f32x2* rope) {
  const Geo g = geo(launder(tid));
  const int tokb = launder(tok0 + g.wc * 32 + g.fr);
  const int base = tokb * ld + col0 + g.wr * 64 + g.fq * 4;
#pragma unroll
  for (int ai = 0; ai < 2; ++ai)
#pragma unroll
    for (int bj = 0; bj < 2; ++bj)
#pragma unroll
      for (int n = 0; n < 2; ++n) {
        bf16_t* drow = dst + (base + (bj * 128 + n * 16) * ld + ai * 128);
        if ((mode & EP_ROPE) && g.wr == 0) {
          const int tok = tokb + bj * 128 + n * 16;
          const f32x2* cs = rope + (tok & (SEQ - 1)) * 16 + g.fq * 4;
          const f32x4 x1 = acc[ai][bj][0][n], x2 = acc[ai][bj][1][n];
#pragma unroll
          for (int j = 0; j < 4; ++j) { const f32x2 c = cs[j]; acc[ai][bj][0][n][j] = x1[j] * c.x - x2[j] * c.y; acc[ai][bj][1][n][j] = x2[j] * c.x + x1[j] * c.y; }
        }
        if (mode & EP_KFRAG) {
          const int tok = tokb + bj * 128 + n * 16, key = tok & (ld * 32 - 1);
          const int head = (col0 >> 7) + ai;
          bf16_t* kp = dst + ((size_t)((head * ld + (key >> 5)) * 8 + g.wr * 4) * 2 + (g.fq >> 1)) * 256 + (key & 31) * 8 + (g.fq & 1) * 512;
#pragma unroll
          for (int m = 0; m < 4; m += 2) *(u32x4*)(kp + m * 512) = widen_pair(pk4(acc[ai][bj][m][n]), pk4(acc[ai][bj][m + 1][n]));
        } else {
          bf16_t* drow2 = drow + ((g.fq & 1) ? 12 : 0);
#pragma unroll
          for (int m = 0; m < 4; m += 2) {
            f32x4 v = acc[ai][bj][m][n], u = acc[ai][bj][m + 1][n];
            if (mode & EP_SILU) {
              v[0] = silu_f(v[0]); v[1] = silu_f(v[1]); v[2] = silu_f(v[2]); v[3] = silu_f(v[3]);
              u[0] = silu_f(u[0]); u[1] = silu_f(u[1]); u[2] = silu_f(u[2]); u[3] = silu_f(u[3]);
            }
            *(u32x4*)(drow2 + m * 16) = widen_pair(pk4(v), pk4(u));
          }
        }
        __builtin_amdgcn_sched_barrier(0);
      }
}
DI void epi_vfrag(const int tid, f32x4 (&acc)[2][2][4][2], bf16_t* dstF, int ntile, int s0, int head0) {
  const Geo g = geo(launder(tid));
  const int lanepart = launder(((g.fq & 1) * 32 + g.fr) * 8);
#pragma unroll
  for (int ai = 0; ai < 2; ++ai)
#pragma unroll
    for (int bj = 0; bj < 2; ++bj)
#pragma unroll
      for (int m = 0; m < 4; m += 2)
#pragma unroll
        for (int n = 0; n < 2; ++n) {
          const int ms = m + (g.fq >> 1);
          const int kt = (s0 >> 5) + ai * 4 + g.wr * 2 + (ms >> 1);
          const size_t idx = ((size_t)(((head0 + bj) * ntile + kt) * 4 + g.wc) * 2 + (ms & 1)) * 512 + n * 128 + lanepart;
          *(u32x4*)(dstF + idx) = widen32_pair(pk4(acc[ai][bj][m][n]), pk4(acc[ai][bj][m + 1][n]));
        }
}
DI void epi_transposed(const int tid, f32x4 (&acc)[2][2][4][2], bf16_t* dstT, int slen, int s0, int feat0) {
  const Geo g = geo(launder(tid));
  const int featb = launder(feat0 + g.wc * 32 + g.fr);
  const int base = featb * slen + s0 + g.wr * 64 + (g.fq & 1) * 8 + (g.fq >> 1) * 16;
#pragma unroll
  for (int ai = 0; ai < 2; ++ai)
#pragma unroll
    for (int bj = 0; bj < 2; ++bj)
#pragma unroll
      for (int m = 0; m < 4; m += 2)
#pragma unroll
        for (int n = 0; n < 2; ++n)
          *(u32x4*)(dstT + (base + (bj * 128 + n * 16) * slen + ai * 128 + m * 16)) = widen32_pair(pk4(acc[ai][bj][m][n]), pk4(acc[ai][bj][m + 1][n]));
}
DI void epi_gate(const int tid, f32x4 (&acc)[2][2][4][2], const bf16_t* T, bf16_t* Y, int tok0, int col0, bool first) {
  const Geo g = geo(launder(tid));
  const int tokb = launder(tok0 + g.wc * 32 + g.fr);
  const int base = tokb * DM + col0 + g.wr * 64 + g.fq * 4 + ((g.fq & 1) ? 12 : 0);
#pragma unroll
  for (int ai = 0; ai < 2; ++ai)
#pragma unroll
    for (int bj = 0; bj < 2; ++bj)
#pragma unroll
      for (int n = 0; n < 2; ++n)
#pragma unroll
        for (int m = 0; m < 4; m += 2) {
          const int off = base + (bj * 128 + n * 16) * DM + ai * 128 + m * 16;
          u32x2 ta, tb; unwiden_pair(*(const u32x4*)(T + off), ta, tb);
          const f32x4 a = acc[ai][bj][m][n], b = acc[ai][bj][m + 1][n];
          f32x4 ya, yb;
          ya[0] = sigmoid_f(a[0]) * bf_lo(ta.x); ya[1] = sigmoid_f(a[1]) * bf_hi(ta.x); ya[2] = sigmoid_f(a[2]) * bf_lo(ta.y); ya[3] = sigmoid_f(a[3]) * bf_hi(ta.y);
          yb[0] = sigmoid_f(b[0]) * bf_lo(tb.x); yb[1] = sigmoid_f(b[1]) * bf_hi(tb.x); yb[2] = sigmoid_f(b[2]) * bf_lo(tb.y); yb[3] = sigmoid_f(b[3]) * bf_hi(tb.y);
          if (!first) {
            u32x2 oa, ob; unwiden_pair(*(const u32x4*)(Y + off), oa, ob);
            ya[0] += bf_lo(oa.x); ya[1] += bf_hi(oa.x); ya[2] += bf_lo(oa.y); ya[3] += bf_hi(oa.y);
            yb[0] += bf_lo(ob.x); yb[1] += bf_hi(ob.x); yb[2] += bf_lo(ob.y); yb[3] += bf_hi(ob.y);
          }
          *(u32x4*)(Y + off) = widen_pair(pk4(ya), pk4(yb));
        }
}
DI void epi_out(const int tid, f32x4 (&acc)[2][2][4][2], const float* x, float* out, float* rowss, int tok0, int col0) {
  const Geo g = geo(launder(tid));
  const int tokb = launder(tok0 + g.wc * 32 + g.fr);
  const int base = tokb * DM + col0 + g.wr * 64 + g.fq * 4;
#pragma unroll
  for (int bj = 0; bj < 2; ++bj)
#pragma unroll
    for (int n = 0; n < 2; ++n) {
      float ss = 0.f;
#pragma unroll
      for (int ai = 0; ai < 2; ++ai)
#pragma unroll
        for (int m = 0; m < 4; ++m) {
          const int off = base + (bj * 128 + n * 16) * DM + ai * 128 + m * 16;
          const f32x4 xv = *(const f32x4*)(x + off);
          const f32x4 z = xv + acc[ai][bj][m][n];
          *(f32x4*)(out + off) = z;
          ss += z[0] * z[0] + z[1] * z[1] + z[2] * z[2] + z[3] * z[3];
        }
      ss += __shfl_xor(ss, 16); ss += __shfl_xor(ss, 32);
      if (g.fq == 0) atomicAdd(rowss + (tokb + bj * 128 + n * 16), ss);
    }
}

DI void epi_out_norm(const int tid, f32x4 (&acc)[2][2][4][2], const float* x, float* out, float* rowss, unsigned* cnt, const float* gfin,
                     int tok0, int col0, LAS unsigned* lcnt) {
  const Geo g = geo(launder(tid));
  const int lane = tid & 63;
  const int tokb = launder(tok0 + g.wc * 32 + g.fr);
  const int base = tokb * DM + col0 + g.wr * 64 + g.fq * 4;
#pragma unroll
  for (int bj = 0; bj < 2; ++bj)
#pragma unroll
    for (int n = 0; n < 2; ++n) {
      float ss = 0.f;
#pragma unroll
      for (int ai = 0; ai < 2; ++ai)
#pragma unroll
        for (int m = 0; m < 4; ++m) {
          const int off = base + (bj * 128 + n * 16) * DM + ai * 128 + m * 16;
          const f32x4 xv = *(const f32x4*)(x + off);
          const f32x4 z = xv + acc[ai][bj][m][n];
          acc[ai][bj][m][n] = z;
          ss += z[0] * z[0] + z[1] * z[1] + z[2] * z[2] + z[3] * z[3];
        }
      ss += __shfl_xor(ss, 16); ss += __shfl_xor(ss, 32);
      if (g.fq == 0) __hip_atomic_fetch_add(rowss + (tokb + bj * 128 + n * 16), ss, __ATOMIC_RELAXED, __HIP_MEMORY_SCOPE_AGENT);
    }
  asm volatile("s_waitcnt vmcnt(0)" ::: "memory");
  if (lane == 0) {
    const unsigned old = __hip_atomic_fetch_add((unsigned*)lcnt, 1u, __ATOMIC_RELAXED, __HIP_MEMORY_SCOPE_WORKGROUP);
    if (old == 7u) {
      __hip_atomic_store((unsigned*)lcnt, 0u, __ATOMIC_RELAXED, __HIP_MEMORY_SCOPE_WORKGROUP);
      __builtin_amdgcn_fence(__ATOMIC_RELEASE, "agent");
      __hip_atomic_fetch_add(cnt, 1u, __ATOMIC_RELAXED, __HIP_MEMORY_SCOPE_AGENT);
    }
  }
  while (__hip_atomic_load(cnt, __ATOMIC_RELAXED, __HIP_MEMORY_SCOPE_AGENT) < 4u) __builtin_amdgcn_s_sleep(1);
  __builtin_amdgcn_fence(__ATOMIC_ACQUIRE, "agent");
  f32x4 gfv[2][4];
#pragma unroll
  for (int ai = 0; ai < 2; ++ai)
#pragma unroll
    for (int m = 0; m < 4; ++m) gfv[ai][m] = *(const f32x4*)(gfin + col0 + g.wr * 64 + g.fq * 4 + ai * 128 + m * 16);
#pragma unroll
  for (int bj = 0; bj < 2; ++bj)
#pragma unroll
    for (int n = 0; n < 2; ++n) {
      const float tot = __hip_atomic_load(rowss + (tokb + bj * 128 + n * 16), __ATOMIC_RELAXED, __HIP_MEMORY_SCOPE_AGENT);
      const float rs = rsqrtf(tot * (1.f / DM) + 1e-6f);
#pragma unroll
      for (int ai = 0; ai < 2; ++ai)
#pragma unroll
        for (int m = 0; m < 4; ++m) {
          const int off = base + (bj * 128 + n * 16) * DM + ai * 128 + m * 16;
          const f32x4 gg = gfv[ai][m];
          const f32x4 z = acc[ai][bj][m][n];
          f32x4 o; o[0] = z[0] * rs * gg[0]; o[1] = z[1] * rs * gg[1]; o[2] = z[2] * rs * gg[2]; o[3] = z[3] * rs * gg[3];
          *(f32x4*)(out + off) = o;
        }
    }
}

DI void p0_transpose_item(const float* W, int K, int N, bf16_t* WT, LAS float* scr, int item, int lane) {
  const int nblk = N / 32, kb = item / nblk, nb = item % nblk, k0 = 64 * kb, n0 = 32 * nb;
#pragma unroll 8
  for (int i = 0; i < 32; ++i) { const int kk = 2 * i + (lane >> 5); scr[kk * 33 + (lane & 31)] = W[(size_t)(k0 + kk) * N + n0 + (lane & 31)]; }
  lds_wait();
  const int c = lane & 7;
#pragma unroll
  for (int j = 0; j < 4; ++j) {
    const int n = (lane >> 3) + 8 * j; const LAS float* s = scr + (8 * c) * 33 + n;
    u32x4 o; o.x = pk2(s[0 * 33], s[1 * 33]); o.y = pk2(s[2 * 33], s[3 * 33]); o.z = pk2(s[4 * 33], s[5 * 33]); o.w = pk2(s[6 * 33], s[7 * 33]);
    *(u32x4*)(WT + (size_t)(n0 + n) * K + k0 + 8 * c) = o;
  }
  lds_wait();
}
DI void rms_row_bf16(const float* xr, const float* gw, bf16_t* orow, int lane) {
  f32x4 v[4]; float s = 0.f;
#pragma unroll
  for (int j = 0; j < 4; ++j) { v[j] = ((const f32x4*)xr)[lane + 64 * j]; s += v[j][0] * v[j][0] + v[j][1] * v[j][1] + v[j][2] * v[j][2] + v[j][3] * v[j][3]; }
  s = wave_sum(s);
  const float rs = rsqrtf(s * (1.f / DM) + 1e-6f);
#pragma unroll
  for (int j = 0; j < 4; ++j) {
    const f32x4 gg = ((const f32x4*)gw)[lane + 64 * j];
    u32x2 o; o.x = pk2(v[j][0] * rs * gg[0], v[j][1] * rs * gg[1]); o.y = pk2(v[j][2] * rs * gg[2], v[j][3] * rs * gg[3]);
    *(u32x2*)(orow + 4 * (lane + 64 * j)) = o;
  }
}
DI void phase0(const Params& p, LAS char* lds, const int wv) {
  const int tid = make_tid(wv), wave = tid >> 6, lane = tid & 63, G = gridDim.x;
  const int gw = blockIdx.x * 8 + wave, NGW = G * 8;
  const size_t gt = (size_t)blockIdx.x * NTHREADS + tid, NGT = (size_t)G * NTHREADS;
  char* ws = p.ws;
  if (gt < 144) ((unsigned*)(ws + OFF_BAR))[gt] = 0u;
  if (gt < 24 * 32) ((unsigned*)(ws + OFF_GCNT))[gt] = 0u;
  if (gt < 128) ((unsigned*)(ws + OFF_C5))[gt] = 0u;
  for (size_t i = gt; i < 6 * 4 * 8 * 64 * 8; i += NGT) {
    const int e = (int)(i & 7), ln = (int)((i >> 3) & 63), ks = (int)((i >> 9) & 7), T = (int)((i >> 12) & 3), g = (int)(i >> 14);
    const int t = T * 32 + (ln & 31), sidx = 16 * ks + 8 * (e >> 2) + 4 * (ln >> 5) + (e & 3);
    const float v = sidx <= t ? p.w_sp[((size_t)g * 128 + t) * 128 + sidx] : 0.f;
    ((bf16_t*)(ws + OFF_WF))[i] = (bf16_t)(pk2(v, 0.f) & 0xffffu);
  }
  for (size_t i = gt; i < MTOK; i += NGT) ((float*)(ws + OFF_ROWSS))[i] = 0.f;
  for (size_t i = gt; i < (size_t)SEQ * 16; i += NGT) {
    const int pos = (int)(i >> 4), f = (int)(i & 15);
    const float inv = powf(500000.0f, -(float)f * (1.f / 16.f));
    const float ang = (float)pos * inv;
    f32x2 cs; cs.x = cosf(ang); cs.y = sinf(ang);
    ((f32x2*)(ws + OFF_ROPE))[i] = cs;
  }
  f32x4 gx[4];
#pragma unroll
  for (int j = 0; j < 2; ++j) { gx[2 * j] = ((const f32x4*)p.norm_g)[2 * (lane + 64 * j)]; gx[2 * j + 1] = ((const f32x4*)p.norm_g)[2 * (lane + 64 * j) + 1]; }
  for (int r0 = gw; r0 < MTOK + NB * 256; r0 += 4 * NGW) {
    f32x4 v[4][4]; float ss[4]; bf16_t* osel[4]; bool ok[4], ismem[4];
#pragma unroll
    for (int k = 0; k < 4; ++k) {
      const int r = r0 + k * NGW;
      ok[k] = r < MTOK + NB * 256;
      const int rc = ok[k] ? r : r0;
      const float* xr;
      ismem[k] = rc >= MTOK;
      if (!ismem[k]) { xr = p.x + (size_t)rc * DM; osel[k] = (bf16_t*)(ws + OFF_HB) + (size_t)rc * DM; }
      else { const int m = rc - MTOK; xr = p.mem + (size_t)m * DM; osel[k] = (bf16_t*)(ws + OFF_MEMN) + (size_t)m * DM; }
#pragma unroll
      for (int j = 0; j < 2; ++j) { v[k][2 * j] = ((const f32x4*)xr)[2 * (lane + 64 * j)]; v[k][2 * j + 1] = ((const f32x4*)xr)[2 * (lane + 64 * j) + 1]; }
    }
#pragma unroll
    for (int k = 0; k < 4; ++k) {
      float s_ = 0.f;
#pragma unroll
      for (int j = 0; j < 4; ++j) s_ += v[k][j][0] * v[k][j][0] + v[k][j][1] * v[k][j][1] + v[k][j][2] * v[k][j][2] + v[k][j][3] * v[k][j][3];
      ss[k] = s_;
    }
#pragma unroll
    for (int o = 1; o < 64; o <<= 1) {
#pragma unroll
      for (int k = 0; k < 4; ++k) ss[k] += __shfl_xor(ss[k], o);
    }
#pragma unroll
    for (int k = 0; k < 4; ++k) {
      if (ok[k]) {
        const float rs = rsqrtf(ss[k] * (1.f / DM) + 1e-6f);
#pragma unroll
        for (int j = 0; j < 2; ++j) {
          f32x4 g0 = gx[2 * j], g1 = gx[2 * j + 1];
          if (ismem[k]) { g0 = ((const f32x4*)p.mem_norm_g)[2 * (lane + 64 * j)]; g1 = ((const f32x4*)p.mem_norm_g)[2 * (lane + 64 * j) + 1]; }
          const f32x4 a = v[k][2 * j], c = v[k][2 * j + 1];
          u32x4 o; o.x = pk2(a[0] * rs * g0[0], a[1] * rs * g0[1]); o.y = pk2(a[2] * rs * g0[2], a[3] * rs * g0[3]);
          o.z = pk2(c[0] * rs * g1[0], c[1] * rs * g1[1]); o.w = pk2(c[2] * rs * g1[2], c[3] * rs * g1[3]);
          *(u32x4*)(osel[k] + 8 * (lane + 64 * j)) = o;
        }
      }
    }
  }
  LAS float* scr = (LAS float*)(lds + wave * 8448);
  constexpr int I_IN = 16 * (INW / 32), I_MKV = 16 * 32, I_A = 12 * 32, I_C = 8 * 32, I_O = 16 * 32;
  constexpr int NITEMS = I_IN + I_MKV + 2 * I_A + I_C + I_O;
  for (int it = gw; it < NITEMS; it += NGW) {
    int r = it;
    if (r < I_IN) { p0_transpose_item(p.w_in, 1024, INW, (bf16_t*)(ws + OFF_WIN), scr, r, lane); continue; } r -= I_IN;
    if (r < I_MKV) { p0_transpose_item(p.w_mkv, 1024, 1024, (bf16_t*)(ws + OFF_WMKV), scr, r, lane); continue; } r -= I_MKV;
    if (r < I_A) { p0_transpose_item(p.w_a, 768, 1024, (bf16_t*)(ws + OFF_WA), scr, r, lane); continue; } r -= I_A;
    if (r < I_A) { p0_transpose_item(p.w_b, 768, 1024, (bf16_t*)(ws + OFF_WB), scr, r, lane); continue; } r -= I_A;
    if (r < I_C) { p0_transpose_item(p.w_c, 512, 1024, (bf16_t*)(ws + OFF_WC), scr, r, lane); continue; } r -= I_C;
    p0_transpose_item(p.w_out, 1024, 1024, (bf16_t*)(ws + OFF_WO), scr, r, lane);
  }
}

struct P1Ops { const bf16_t *A, *B; int tt, ct; bool memkv, tr; };
DI P1Ops p1_ops(char* ws, int L, bool swz, int xcd) {
  P1Ops o;
  if (swz) {
    if (L < 400) { const int grp = L / 200, r = L % 200; o.tt = xcd * 16 + grp * 8 + (r & 7); o.ct = r >> 3; o.memkv = false; }
    else { o.memkv = true; const int t = xcd * 2 + (L - 400); o.tt = t >> 2; o.ct = t & 3; }
  } else {
    if (L < 3200) { o.tt = L / 25; o.ct = L % 25; o.memkv = false; } else { o.memkv = true; o.tt = (L - 3200) >> 2; o.ct = (L - 3200) & 3; }
  }
  const bf16_t *Wt, *Xt;
  if (!o.memkv) {
    Wt = (const bf16_t*)(ws + OFF_WIN) + (size_t)o.ct * 256 * DM; Xt = (const bf16_t*)(ws + OFF_HB) + (size_t)o.tt * 256 * DM;
    o.tr = (o.ct >= 6 && o.ct < 9) || (o.ct >= 15 && o.ct < 18);
  } else {
    Wt = (const bf16_t*)(ws + OFF_WMKV) + (size_t)o.ct * 256 * DM; Xt = (const bf16_t*)(ws + OFF_MEMN) + (size_t)o.tt * 256 * DM;
    o.tr = o.ct >= 2;
  }
  o.A = o.tr ? Xt : Wt; o.B = o.tr ? Wt : Xt;
  return o;
}
DI void phase1(const Params& p, LAS char* lds, const int wv) {
  char* ws = p.ws;
  const int tid = make_tid(wv);
  const int G = gridDim.x, b = blockIdx.x;
  const f32x2* rope = (const f32x2*)(ws + OFF_ROPE);
  const bool swz = (G % 8) == 0;
  const int per = swz ? G / 8 : G, xcd = swz ? (b & 7) : 0, slot = swz ? (b >> 3) : b;
  const int LMAX = swz ? 402 : 3216;
  if (slot >= LMAX) return;
  { const P1Ops o = p1_ops(ws, slot, swz, xcd); gemm_begin(tid, o.A, o.B, DM, lds); }
  for (int L = slot; L < LMAX; L += per) {
    const P1Ops o = p1_ops(ws, L, swz, xcd);
    const P1Ops nx = p1_ops(ws, (L + per < LMAX) ? L + per : L, swz, xcd);
    const int tt = o.tt, ct = o.ct; const bool tr = o.tr;
    bf16_t* dst; int dld, dcol, mode, slen, s0, tok0;
    if (!o.memkv) {
      tok0 = tt * 256; slen = SEQ; s0 = (tt & 31) * 256;
      const int bb = tt >> 5;
      if (ct < 3) { dst = (bf16_t*)(ws + OFF_Q); dld = AW; dcol = ct * 256; mode = EP_ROPE; }
      else if (ct < 6) { dst = (bf16_t*)(ws + OFF_K) + (size_t)bb * 6 * 256 * 4096; dld = 256; dcol = (ct - 3) * 256; mode = EP_ROPE | EP_KFRAG; }
      else if (ct < 9) { dst = (bf16_t*)(ws + OFF_VT) + (size_t)bb * 6 * 256 * 4096; dld = 1; dcol = (ct - 6) * 2; mode = EP_PLAIN; }
      else if (ct < 12) { dst = (bf16_t*)(ws + OFF_GA); dld = AW; dcol = (ct - 9) * 256; mode = EP_SILU; }
      else if (ct < 15) { dst = (bf16_t*)(ws + OFF_UB); dld = AW; dcol = (ct - 12) * 256; mode = EP_PLAIN; }
      else if (ct < 18) { dst = (bf16_t*)(ws + OFF_VBT) + (size_t)bb * AW * SEQ; dld = 0; dcol = (ct - 15) * 256; mode = EP_PLAIN; }
      else if (ct < 21) { dst = (bf16_t*)(ws + OFF_GB); dld = AW; dcol = (ct - 18) * 256; mode = EP_SILU; }
      else if (ct < 23) { dst = (bf16_t*)(ws + OFF_QC); dld = CW; dcol = (ct - 21) * 256; mode = EP_PLAIN; }
      else { dst = (bf16_t*)(ws + OFF_GC); dld = CW; dcol = (ct - 23) * 256; mode = EP_SILU; }
    } else {
      tok0 = tt * 256; slen = 256; s0 = 0; mode = EP_PLAIN;
      if (!tr) { dst = (bf16_t*)(ws + OFF_MEMK) + (size_t)tt * 4 * 8 * 4096; dld = 8; dcol = ct * 256; mode = EP_KFRAG; }
      else { dst = (bf16_t*)(ws + OFF_MEMVT) + (size_t)tt * 4 * 8 * 4096; dld = 1; dcol = (ct - 2) * 2; }
    }
    f32x4 acc[2][2][4][2];
    gemm_unit(tid, o.A, o.B, DM, DM, nx.A, nx.B, DM, lds, acc);
    if (!tr) epi_rowmajor(tid, acc, dst, dld, tok0, dcol, mode, rope);
    else if (dld == 1) epi_vfrag(tid, acc, dst, slen >> 5, s0, dcol);
    else epi_transposed(tid, acc, dst, slen, s0, dcol);
  }
  gemm_end(tid);
}

DI void kstat_item(const int tid, const bf16_t* blk, bf16_t* kmh, const int blkidx, float* max2_out, LAS char* lds) {
  const int ks = tid >> 6, lane = tid & 63;
  LAS float* n2p = (LAS float*)lds;
  LAS float* redm = n2p + 4096;
  __syncthreads();
  float cs[8];
#pragma unroll
  for (int e = 0; e < 8; ++e) cs[e] = 0.f;
#pragma unroll
  for (int kt = 0; kt < 8; ++kt) {
    const u32x4 v = *(const u32x4*)(blk + (size_t)((kt * 8 + ks) * 64 + lane) * 8);
    const float f[8] = {bf_lo(v.x), bf_hi(v.x), bf_lo(v.y), bf_hi(v.y), bf_lo(v.z), bf_hi(v.z), bf_lo(v.w), bf_hi(v.w)};
    float n2 = 0.f;
#pragma unroll
    for (int e = 0; e < 8; ++e) { cs[e] += f[e]; n2 += f[e] * f[e]; }
    n2p[(ks * 2 + (lane >> 5)) * 256 + kt * 32 + (lane & 31)] = n2;
  }
#pragma unroll
  for (int e = 0; e < 8; ++e) {
    float c = cs[e];
    c += __shfl_xor(c, 1); c += __shfl_xor(c, 2); c += __shfl_xor(c, 4); c += __shfl_xor(c, 8); c += __shfl_xor(c, 16);
    cs[e] = c * (1.f / 256.f);
  }
  if (kmh && (lane & 31) == 0) {
    u32x4 hi, lo;
    hi.x = pk2(cs[0], cs[1]); hi.y = pk2(cs[2], cs[3]); hi.z = pk2(cs[4], cs[5]); hi.w = pk2(cs[6], cs[7]);
    lo.x = pk2(cs[0] - bf_lo(hi.x), cs[1] - bf_hi(hi.x)); lo.y = pk2(cs[2] - bf_lo(hi.y), cs[3] - bf_hi(hi.y));
    lo.z = pk2(cs[4] - bf_lo(hi.z), cs[5] - bf_hi(hi.z)); lo.w = pk2(cs[6] - bf_lo(hi.w), cs[7] - bf_hi(hi.w));
    bf16_t* d = kmh + ((size_t)(ks * 64 + (lane >> 5) * 32 + blkidx)) * 8;
    *(u32x4*)d = hi; *(u32x4*)(d + 98304) = lo;
  }
  __syncthreads();
  if (tid < 256) {
    float n = 0.f;
#pragma unroll
    for (int k = 0; k < 16; ++k) n += n2p[k * 256 + tid];
    n = wave_max(n);
    if ((tid & 63) == 0) redm[tid >> 6] = n;
  }
  __syncthreads();
  if (tid == 0) *max2_out = fmaxf(fmaxf(redm[0], redm[1]), fmaxf(redm[2], redm[3]));
  __syncthreads();
}

DI u32x4 pack_w(const f32x4 wa, const f32x4 wb) { u32x4 o; o.x = pk2(wa[0], wa[1]); o.y = pk2(wa[2], wa[3]); o.z = pk2(wb[0], wb[1]); o.w = pk2(wb[2], wb[3]); return o; }
DI u32x4 pack_w_masked(const f32x4 wa, const f32x4 wb, const int sa, const int t) {
  u32x4 o; const int sb = sa + 8;
  o.x = pk2(sa + 0 <= t ? wa[0] : 0.f, sa + 1 <= t ? wa[1] : 0.f); o.y = pk2(sa + 2 <= t ? wa[2] : 0.f, sa + 3 <= t ? wa[3] : 0.f);
  o.z = pk2(sb + 0 <= t ? wb[0] : 0.f, sb + 1 <= t ? wb[1] : 0.f); o.w = pk2(sb + 2 <= t ? wb[2] : 0.f, sb + 3 <= t ? wb[3] : 0.f);
  return o;
}
DI void gmlp_item(const int tid, const Params& p, LAS char* lds, int item) {
  char* ws = p.ws;
  const int w = tid >> 6, lane = tid & 63, r = lane & 31, hh = lane >> 5;
  const int b = item >> 6, ch = item & 63, s0 = ch * 128, tok0 = b * SEQ + s0;
  const bf16_t* VBT = (const bf16_t*)(ws + OFF_VBT) + (size_t)b * AW * SEQ + s0;
  LAS float* red = (LAS float*)lds;
  LAS float* red2 = red + 4096;
  LAS float* ra = red + 8192;
  LAS float* rb = ra + 128;
  __syncthreads();
  {
    const int oct = tid & 15, cpart = tid >> 4;
    float sum[8], sq[8];
#pragma unroll
    for (int e = 0; e < 8; ++e) { sum[e] = 0.f; sq[e] = 0.f; }
#pragma unroll 8
    for (int i = 0; i < 24; ++i) {
      const u32x4 v = *(const u32x4*)(VBT + (size_t)(cpart + 32 * i) * SEQ + oct * 8);
      const float f[8] = {bf_lo(v.x), bf_hi(v.x), bf_lo(v.y), bf_hi(v.y), bf_lo(v.z), bf_hi(v.z), bf_lo(v.w), bf_hi(v.w)};
#pragma unroll
      for (int e = 0; e < 8; ++e) { sum[e] += f[e]; sq[e] += f[e] * f[e]; }
    }
#pragma unroll
    for (int e = 0; e < 8; ++e) { red[cpart * 128 + oct * 8 + e] = sum[e]; red2[cpart * 128 + oct * 8 + e] = sq[e]; }
    __syncthreads();
    if (tid < 128) {
      float su = 0.f, s2 = 0.f;
#pragma unroll 8
      for (int k = 0; k < 32; ++k) { su += red[k * 128 + tid]; s2 += red2[k * 128 + tid]; }
      const float mu = su * (1.f / AW); const float var = fmaxf(s2 * (1.f / AW) - mu * mu, 0.f);
      const float rr = rsqrtf(var + 1e-6f);
      ra[tid] = rr; rb[tid] = mu * rr;
    }
    __syncthreads();
  }
  const int ct = w & 3, gh = w >> 2;
  const bf16_t* UB = (const bf16_t*)(ws + OFF_UB);
  bf16_t* OB = (bf16_t*)((char*)p.out + DO_OB);
  const bf16_t* GB = (const bf16_t*)(ws + OFF_GB);
#pragma unroll 1
  for (int it = 0; it < 3; ++it) {
    const int g = gh * 3 + it;
    f32x16 acc[4];
#pragma unroll
    for (int T = 0; T < 4; ++T)
#pragma unroll
      for (int i = 0; i < 16; ++i) acc[T][i] = 0.f;
    const int c = g * 128 + ct * 32 + r;
    const float lgc = p.ln_g[c];
    const bf16_t* wf = (const bf16_t*)(ws + OFF_WF) + (size_t)(g * 4 * 8) * 512 + lane * 8;
#pragma unroll
    for (int ks = 0; ks < 8; ++ks) {
      const u32x4 raw = *(const u32x4*)(VBT + (size_t)c * SEQ + 16 * ks + 8 * hh);
      const f32x4 r0 = *(const LAS f32x4*)(ra + 16 * ks + 8 * hh), r1 = *(const LAS f32x4*)(ra + 16 * ks + 8 * hh + 4);
      const f32x4 m0 = *(const LAS f32x4*)(rb + 16 * ks + 8 * hh), m1 = *(const LAS f32x4*)(rb + 16 * ks + 8 * hh + 4);
      u32x4 a;
      a.x = pk2((bf_lo(raw.x) * r0[0] - m0[0]) * lgc, (bf_hi(raw.x) * r0[1] - m0[1]) * lgc);
      a.y = pk2((bf_lo(raw.y) * r0[2] - m0[2]) * lgc, (bf_hi(raw.y) * r0[3] - m0[3]) * lgc);
      a.z = pk2((bf_lo(raw.z) * r1[0] - m1[0]) * lgc, (bf_hi(raw.z) * r1[1] - m1[1]) * lgc);
      a.w = pk2((bf_lo(raw.w) * r1[2] - m1[2]) * lgc, (bf_hi(raw.w) * r1[3] - m1[3]) * lgc);
      const bf16x8 af = __builtin_bit_cast(bf16x8, a);
#pragma unroll
      for (int T = 0; T < 4; ++T) {
        if (ks <= 2 * T + 1) {
          acc[T] = mfma32(af, *(const bf16x8*)(wf + (size_t)((T * 8 + ks) * 512)), acc[T]);
        }
      }
      if (ks & 1) __builtin_amdgcn_sched_barrier(0);
    }
#pragma unroll
    for (int T = 0; T < 4; ++T) {
      const int t = T * 32 + r;
      const float bias = p.b_sp[g * 128 + t];
      const size_t rowoff = (size_t)(tok0 + t) * AW + g * 128 + ct * 32 + 8 * hh;
#pragma unroll
      for (int i4 = 0; i4 < 4; i4 += 2) {
        const size_t off = rowoff + 8 * i4;
        u32x2 ua, ub2, ga, gb2;
        unwiden32_pair(*(const u32x4*)(UB + off), ua, ub2);
        unwiden32_pair(*(const u32x4*)(GB + off), ga, gb2);
        f32x4 oa, ob;
#pragma unroll
        for (int e = 0; e < 4; ++e) {
          const float a0 = acc[T][4 * i4 + e], a1 = acc[T][4 * i4 + 4 + e];
          const unsigned uw0 = (e < 2) ? ua.x : ua.y, gw0 = (e < 2) ? ga.x : ga.y, uw1 = (e < 2) ? ub2.x : ub2.y, gw1 = (e < 2) ? gb2.x : gb2.y;
          const float u0 = (e & 1) ? bf_hi(uw0) : bf_lo(uw0), g0 = (e & 1) ? bf_hi(gw0) : bf_lo(gw0);
          const float u1 = (e & 1) ? bf_hi(uw1) : bf_lo(uw1), g1 = (e & 1) ? bf_hi(gw1) : bf_lo(gw1);
          oa[e] = u0 * (a0 + bias) * g0; ob[e] = u1 * (a1 + bias) * g1;
        }
        *(u32x4*)(OB + off) = widen32_pair(pk4(oa), pk4(ob));
      }
    }
  }
}

DI void phase2(const Params& p, LAS char* lds, const int wv) {
  char* ws = p.ws;
  const int tid = make_tid(wv);
  for (int it = blockIdx.x; it < 256 + 768 + 16; it += gridDim.x) {
    if (it < 256) { for (int rg = 0; rg < REP2G; ++rg) gmlp_item(tid, p, lds, it); }
    else if (it < 1024) {
      const int k = it - 256, blk = k & 31, bh = k >> 5, h = bh % 6, b = bh / 6;
      kstat_item(tid, (const bf16_t*)(ws + OFF_K) + ((size_t)bh * 256 + blk * 8) * 4096,
                 (bf16_t*)(ws + OFF_KMEAN) + (size_t)bh * 4096, blk, (float*)(ws + OFF_KMAX2) + k, lds);
    } else {
      const int k = it - 1024, hd = k & 3, b = k >> 2;
      kstat_item(tid, (const bf16_t*)(ws + OFF_MEMK) + (size_t)k * 8 * 4096, nullptr, 0, (float*)(ws + OFF_MKMAX2) + k, lds);
    }
  }
}

constexpr float ATT_SC = 0.08838834764831845f * 1.4426950408889634f;
DI bf16x8 ldfrag(const bf16_t* p) { return *(const bf16x8*)p; }
DI bf16x8 ldfrag(const LAS bf16_t* p) { return *(const LAS bf16x8*)p; }
template <class KP>
DI void attn_unit(const bf16x8 (&qf)[8], KP Kt, KP Vt, int nkt, float cs, int qpos, int hh, f32x16 (&o)[4], float& lsum) {
  bf16x8 kf[8], vf[8];
#pragma unroll
  for (int f = 0; f < 8; ++f) kf[f] = ldfrag(Kt + f * 512);
#pragma unroll
  for (int f = 0; f < 8; ++f) vf[f] = ldfrag(Vt + f * 512);
#pragma unroll 1
  for (int kt = 0; kt < nkt; ++kt) {
    f32x16 s;
#pragma unroll
    for (int i = 0; i < 16; ++i) s[i] = 0.f;
#pragma unroll
    for (int ks = 0; ks < 8; ++ks) s = mfma32(kf[ks], qf[ks], s);
    const int ktn = (kt + 1 < nkt) ? kt + 1 : kt;
#pragma unroll
    for (int f = 0; f < 8; ++f) kf[f] = ldfrag(Kt + ktn * 4096 + f * 512);
#pragma unroll
    for (int i = 0; i < 16; ++i) {
      const int key = kt * 32 + crow(i, hh);
      float pv = __builtin_amdgcn_exp2f(s[i] * ATT_SC - cs);
      pv = key > qpos ? 0.f : pv;
      lsum += pv; s[i] = pv;
    }
    u32x4 a, b;
    a.x = pk2(s[0], s[1]); a.y = pk2(s[2], s[3]); a.z = pk2(s[4], s[5]); a.w = pk2(s[6], s[7]);
    b.x = pk2(s[8], s[9]); b.y = pk2(s[10], s[11]); b.z = pk2(s[12], s[13]); b.w = pk2(s[14], s[15]);
    const bf16x8 p0 = __builtin_bit_cast(bf16x8, a), p1 = __builtin_bit_cast(bf16x8, b);
#pragma unroll
    for (int dt = 0; dt < 4; ++dt) { o[dt] = mfma32(vf[dt * 2], p0, o[dt]); o[dt] = mfma32(vf[dt * 2 + 1], p1, o[dt]); }
#pragma unroll
    for (int f = 0; f < 8; ++f) vf[f] = ldfrag(Vt + ktn * 4096 + f * 512);
  }
}
template <bool CAUSAL>
DI void attn_unit_lds(const bf16x8 (&qf)[8], const LAS bf16_t* Kt, const LAS bf16_t* Vt, const int nkt, float cs, const int qpos, const int hh, f32x16 (&o)[4], float& lsum) {
  f32x16 zero;
#pragma unroll
  for (int i = 0; i < 16; ++i) zero[i] = 0.f;
  const f32x2 sc2 = {ATT_SC, ATT_SC}, cs2 = {cs, cs};
  f32x2 l2 = {0.f, 0.f};
#pragma unroll 1
  for (int kt = 0; kt < nkt; ++kt) {
    f32x16 s = mfma32(*(const LAS bf16x8*)(Kt + kt * 4096), qf[0], zero);
#pragma unroll
    for (int ks = 1; ks < 8; ++ks) { const bf16x8 kf = *(const LAS bf16x8*)(Kt + kt * 4096 + ks * 512); s = mfma32(kf, qf[ks], s); }
    u32x4 a, b;
    unsigned pk[8];
#pragma unroll
    for (int i = 0; i < 8; ++i) {
      f32x2 t = {s[2 * i], s[2 * i + 1]};
      t = t * sc2 - cs2;
      t.x = __builtin_amdgcn_exp2f(t.x); t.y = __builtin_amdgcn_exp2f(t.y);
      if (CAUSAL) {
        if (kt * 32 + crow(2 * i, hh) > qpos) t.x = 0.f;
        if (kt * 32 + crow(2 * i + 1, hh) > qpos) t.y = 0.f;
      }
      l2 += t;
      pk[i] = pk2(t.x, t.y);
    }
    a.x = pk[0]; a.y = pk[1]; a.z = pk[2]; a.w = pk[3]; b.x = pk[4]; b.y = pk[5]; b.z = pk[6]; b.w = pk[7];
    const bf16x8 p0 = __builtin_bit_cast(bf16x8, a), p1 = __builtin_bit_cast(bf16x8, b);
#pragma unroll
    for (int dt = 0; dt < 4; ++dt) {
      const bf16x8 v0 = *(const LAS bf16x8*)(Vt + kt * 4096 + dt * 1024), v1 = *(const LAS bf16x8*)(Vt + kt * 4096 + dt * 1024 + 512);
      o[dt] = mfma32(v0, p0, o[dt]); o[dt] = mfma32(v1, p1, o[dt]);
    }
  }
  lsum += l2.x + l2.y;
}
DI float kmax_norm(const float* kmax2_bh) {
  float m = 0.f;
#pragma unroll
  for (int k = 0; k < 32; ++k) m = fmaxf(m, kmax2_bh[k]);
  return sqrtf(m);
}
DI float qf_norm2(const bf16x8 (&qf)[8]) {
  float n2 = 0.f;
#pragma unroll
  for (int ks = 0; ks < 8; ++ks) {
    const u32x4 u = __builtin_bit_cast(u32x4, qf[ks]);
    n2 += bf_lo(u.x) * bf_lo(u.x) + bf_hi(u.x) * bf_hi(u.x) + bf_lo(u.y) * bf_lo(u.y) + bf_hi(u.y) * bf_hi(u.y)
        + bf_lo(u.z) * bf_lo(u.z) + bf_hi(u.z) * bf_hi(u.z) + bf_lo(u.w) * bf_lo(u.w) + bf_hi(u.w) * bf_hi(u.w);
  }
  n2 += __shfl_xor(n2, 32);
  return n2;
}
struct T3 { float v1, v2, v3; int i1, i2, i3; };
DI bool t3_better(float v, int b, float w, int j) { return v > w || (v == w && b < j); }
DI T3 top3_insert(T3 t, float v, int blk) {
  const bool g1 = t3_better(v, blk, t.v1, t.i1), g2 = t3_better(v, blk, t.v2, t.i2), g3 = t3_better(v, blk, t.v3, t.i3);
  T3 r;
  r.v3 = g2 ? t.v2 : (g3 ? v : t.v3); r.i3 = g2 ? t.i2 : (g3 ? blk : t.i3);
  r.v2 = g1 ? t.v1 : (g2 ? v : t.v2); r.i2 = g1 ? t.i1 : (g2 ? blk : t.i2);
  r.v1 = g1 ? v : t.v1;               r.i1 = g1 ? blk : t.i1;
  return r;
}

constexpr int MB_K = 0, MB_V = 65536, MB_PRE = 131072, MB_END = MB_PRE + 768 * 4;
DI void stage_kv_block(const int tid, const bf16_t* kblk, const bf16_t* vblk, LAS char* lds) {
  const u32x4* ksrc = (const u32x4*)kblk; const u32x4* vsrc = (const u32x4*)vblk;
  u32x4 kk[8];
#pragma unroll
  for (int i = 0; i < 8; ++i) kk[i] = ksrc[tid + 512 * i];
#pragma unroll
  for (int i = 0; i < 8; ++i) *(LAS u32x4*)(lds + MB_K + (tid + 512 * i) * 16) = kk[i];
  __builtin_amdgcn_sched_barrier(0);
#pragma unroll
  for (int i = 0; i < 8; ++i) kk[i] = vsrc[tid + 512 * i];
#pragma unroll
  for (int i = 0; i < 8; ++i) *(LAS u32x4*)(lds + MB_V + (tid + 512 * i) * 16) = kk[i];
  __builtin_amdgcn_sched_barrier(0);
}
constexpr int MA_CNT = 131072, MA_BASE = MA_CNT + 128, MA_LIST = MA_CNT + 256, MA_END = MA_LIST + 32 * 256 * 2;
DI void store_partial(bf16_t* po, const f32x16 (&o)[4], const int hh) {
#pragma unroll
  for (int dt = 0; dt < 4; ++dt)
#pragma unroll
    for (int i4 = 0; i4 < 4; i4 += 2) {
      f32x4 v, u;
      v[0] = o[dt][4 * i4 + 0]; v[1] = o[dt][4 * i4 + 1]; v[2] = o[dt][4 * i4 + 2]; v[3] = o[dt][4 * i4 + 3];
      u[0] = o[dt][4 * i4 + 4]; u[1] = o[dt][4 * i4 + 5]; u[2] = o[dt][4 * i4 + 6]; u[3] = o[dt][4 * i4 + 7];
      *(u32x4*)(po + dt * 32 + 8 * i4 + 8 * hh) = widen32_pair(pk4(v), pk4(u));
    }
}
DI float* pl_ptr(char* ws, size_t bhq, int slot) { return (float*)(ws + OFF_PL4) + bhq * 4 + slot; }
DI bf16_t* po_slot(char* ws, int slot) { return (bf16_t*)(ws + (slot < 2 ? OFF_PO01 : OFF_PO2)) + (slot < 2 ? (size_t)slot * 24 * SEQ * 128 : 0); }

DI void moba_a_item(const int tid_, const Params& p, LAS char* lds, int item) {
  char* ws = p.ws;
  const int tid = launder(tid_);
  const int w = tid >> 6, lane = tid & 63, r = lane & 31, hh = lane >> 5;
  const int ob = item & 31, bh = item >> 5, h = bh % 6, b = bh / 6;
  LAS int* cnt = (LAS int*)(lds + MA_CNT);
  LAS int* gbase = (LAS int*)(lds + MA_BASE);
  LAS unsigned short* lists = (LAS unsigned short*)(lds + MA_LIST);
  const bf16_t* Q = (const bf16_t*)(ws + OFF_Q);
  const int tokbase = b * SEQ + ob * 256;
  __syncthreads();
  if (tid < 32) cnt[tid] = 0;
  __syncthreads();
  bf16x8 qf[8];
  {
    const bf16_t* qrow = Q + (size_t)(tokbase + 32 * w + r) * AW + h * 128 + 8 * hh;
#pragma unroll
    for (int ks = 0; ks < 8; ++ks) qf[ks] = *(const bf16x8*)(qrow + 16 * ks);
  }
  const float kmaxn = kmax_norm((const float*)(ws + OFF_KMAX2) + bh * 32);
  const float cs_own = sqrtf(qf_norm2(qf)) * kmaxn * ATT_SC;
  if (ob > 0) {
    f32x16 sc;
#pragma unroll
    for (int i = 0; i < 16; ++i) sc[i] = 0.f;
    const bf16_t* kmh = (const bf16_t*)(ws + OFF_KMEAN) + (size_t)bh * 4096 + lane * 8;
#pragma unroll
    for (int ks = 0; ks < 8; ++ks) {
      sc = mfma32(*(const bf16x8*)(kmh + ks * 512), qf[ks], sc);
      sc = mfma32(*(const bf16x8*)(kmh + 98304 + ks * 512), qf[ks], sc);
    }
    T3 t; t.v1 = t.v2 = t.v3 = -INFINITY; t.i1 = t.i2 = t.i3 = 999;
#pragma unroll
    for (int i = 0; i < 16; ++i) { const int blk = crow(i, hh); const bool ok = blk < ob; t = top3_insert(t, ok ? sc[i] : -INFINITY, ok ? blk : 1000); }
    T3 q;
    q.v1 = __shfl_xor(t.v1, 32); q.v2 = __shfl_xor(t.v2, 32); q.v3 = __shfl_xor(t.v3, 32);
    q.i1 = __shfl_xor(t.i1, 32); q.i2 = __shfl_xor(t.i2, 32); q.i3 = __shfl_xor(t.i3, 32);
    t = top3_insert(t, q.v1, q.i1); t = top3_insert(t, q.v2, q.i2); t = top3_insert(t, q.v3, q.i3);
    if (hh == 0) {
      const unsigned qa = (unsigned)(ob * 256 + 32 * w + r) << 2;
      if (t.i1 < 32) { const int sl = atomicAdd((int*)(cnt + t.i1), 1); lists[t.i1 * 256 + sl] = (unsigned short)(qa | 0u); }
      if (t.i2 < 32) { const int sl = atomicAdd((int*)(cnt + t.i2), 1); lists[t.i2 * 256 + sl] = (unsigned short)(qa | 1u); }
      if (t.i3 < 32) { const int sl = atomicAdd((int*)(cnt + t.i3), 1); lists[t.i3 * 256 + sl] = (unsigned short)(qa | 2u); }
    }
  }
  __syncthreads();
  if (tid < ob) { const int n = cnt[tid]; gbase[tid] = n ? (int)atomicAdd((unsigned*)(ws + OFF_GCNT) + bh * 32 + tid, (unsigned)n) : 0; }
  __syncthreads();
  {
    unsigned short* gl = (unsigned short*)(ws + OFF_GLIST) + (size_t)bh * 32 * SEQ;
#pragma unroll
    for (int k = 0; k < 4; ++k) {
      const int j = w * 4 + k;
      if (j < ob) {
        const int n = cnt[j], gb0 = gbase[j];
        for (int i = lane; i < n; i += 64) gl[(size_t)j * SEQ + gb0 + i] = lists[j * 256 + i];
      }
    }
  }
  {
    f32x16 o[4]; float ls = 0.f;
#pragma unroll
    for (int dt = 0; dt < 4; ++dt)
#pragma unroll
      for (int i = 0; i < 16; ++i) o[dt][i] = 0.f;
    const size_t boff = ((size_t)bh * 256 + ob * 8) * 4096;
    stage_kv_block(tid, (const bf16_t*)(ws + OFF_K) + boff, (const bf16_t*)(ws + OFF_VT) + boff, lds);
    __syncthreads();
    attn_unit_lds<true>(qf, (const LAS bf16_t*)(lds + MB_K) + lane * 8, (const LAS bf16_t*)(lds + MB_V) + lane * 8, w + 1, cs_own, 32 * w + r, hh, o, ls);
    ls += __shfl_xor(ls, 32);
    store_partial((bf16_t*)((char*)p.out + DO_OA) + (size_t)(tokbase + 32 * w + r) * AW + h * 128, o, hh);
    if (hh == 0) *pl_ptr(ws, (size_t)bh * SEQ + ob * 256 + 32 * w + r, 3) = ls;
  }
}

static_assert(MB_END <= LDS_BYTES && MA_END <= LDS_BYTES, "lds");
DI void phase3b(const Params& p, LAS char* lds, const int wv) {
  char* ws = p.ws;
  const int tid0 = make_tid(wv);
  LAS int* pre = (LAS int*)(lds + MB_PRE);
  const unsigned* gcnt = (const unsigned*)(ws + OFF_GCNT);
  __syncthreads();
  {
    const int tid = tid0, w = tid >> 6, lane = tid & 63;
    int c0 = 0, c1 = 0;
    if (tid < 384) { c0 = ((int)gcnt[2 * tid] + 255) >> 8; c1 = ((int)gcnt[2 * tid + 1] + 255) >> 8; }
    int incl = c0 + c1;
#pragma unroll
    for (int d = 1; d < 64; d <<= 1) { const int t = __shfl_up(incl, d); if (lane >= d) incl += t; }
    LAS int* wsum = pre + 768 - 8;
    __syncthreads();
    if (lane == 63) wsum[w] = incl;
    __syncthreads();
    int woff = 0;
    for (int k = 0; k < w; ++k) woff += wsum[k];
    __syncthreads();
    if (tid < 384) { pre[2 * tid] = woff + incl - c1; pre[2 * tid + 1] = woff + incl; }
    __syncthreads();
  }
  const int total = __builtin_amdgcn_readfirstlane(pre[767]);
  const float* kmax2 = (const float*)(ws + OFF_KMAX2);
  const int vblk = ((gridDim.x & 7) == 0) ? (int)((blockIdx.x & 7) * (gridDim.x >> 3) + (blockIdx.x >> 3)) : (int)blockIdx.x;
  const int u_lo = (int)(((long long)vblk * total) / (int)gridDim.x), u_hi = (int)(((long long)(vblk + 1) * total) / (int)gridDim.x);
  int prev_pair = -1;
  for (int u = u_lo; u < u_hi; ++u) {
    const int tid = launder(tid0), w = tid >> 6, lane = tid & 63, r = lane & 31, hh = lane >> 5;
    int lo = 0, hi = 767;
    while (lo < hi) { const int mid = (lo + hi) >> 1; if (pre[mid] > u) hi = mid; else lo = mid + 1; }
    const int pair = __builtin_amdgcn_readfirstlane(lo), bh = pair >> 5, j = pair & 31, h = bh % 6, b = bh / 6;
    const int chunk = __builtin_amdgcn_readfirstlane(u - (pair ? pre[pair - 1] : 0));
    const int n = __builtin_amdgcn_readfirstlane((int)gcnt[pair]);
    if (pair != prev_pair) {
      __syncthreads();
      stage_kv_block(tid, (const bf16_t*)(ws + OFF_K) + ((size_t)bh * 256 + j * 8) * 4096, (const bf16_t*)(ws + OFF_VT) + ((size_t)bh * 256 + j * 8) * 4096, lds);
      __syncthreads();
      prev_pair = pair;
    }
    const int idx = (chunk * 8 + w) * 32 + r;
    if ((chunk * 8 + w) * 32 < n) {
      const unsigned short* gl = (const unsigned short*)(ws + OFF_GLIST) + ((size_t)bh * 32 + j) * SEQ;
      const bool valid = idx < n;
      const unsigned e = gl[valid ? idx : n - 1];
      const int qa = (int)(e >> 2), slot = (int)(e & 3u);
      bf16x8 qf[8];
      {
        const bf16_t* qrow = (const bf16_t*)(ws + OFF_Q) + (size_t)(b * SEQ + qa) * AW + h * 128 + 8 * hh;
#pragma unroll
        for (int ks = 0; ks < 8; ++ks) qf[ks] = *(const bf16x8*)(qrow + 16 * ks);
      }
      const float kmaxn = kmax_norm(kmax2 + bh * 32);
      const float cs = sqrtf(qf_norm2(qf)) * kmaxn * ATT_SC;
      f32x16 o[4]; float ls = 0.f;
#pragma unroll
      for (int dt = 0; dt < 4; ++dt)
#pragma unroll
        for (int i = 0; i < 16; ++i) o[dt][i] = 0.f;
      attn_unit_lds<false>(qf, (const LAS bf16_t*)(lds + MB_K) + lane * 8, (const LAS bf16_t*)(lds + MB_V) + lane * 8, 8, cs, 1 << 30, hh, o, ls);
      ls += __shfl_xor(ls, 32);
      if (valid) {
        store_partial(po_slot(ws, slot) + ((size_t)bh * SEQ + qa) * 128, o, hh);
        if (hh == 0) *pl_ptr(ws, (size_t)bh * SEQ + qa, slot) = ls;
      }
    }
  }
  __syncthreads();
}

DI void phase3c(const Params& p, const int wv) {
  char* ws = p.ws;
  const size_t gt = (size_t)blockIdx.x * NTHREADS + make_tid(wv), NGT = (size_t)gridDim.x * NTHREADS;
  bf16_t* OA = (bf16_t*)((char*)p.out + DO_OA);
  const bf16_t* GA = (const bf16_t*)(ws + OFF_GA);
  const bf16_t* P0 = po_slot(ws, 0); const bf16_t* P1 = po_slot(ws, 1); const bf16_t* P2 = po_slot(ws, 2);
  const f32x4* L4 = (const f32x4*)(ws + OFF_PL4);
  const size_t N = (size_t)MTOK * 6 * 16;
  for (size_t base = gt; base < N; base += NGT * 4) {
    u32x4 vo[4], v0[4], v1[4], v2[4], vg[4]; f32x4 l4[4]; size_t oo[4]; int ns[4];
#pragma unroll
    for (int k = 0; k < 4; ++k) {
      const size_t i0 = base + k * NGT, i = i0 < N ? i0 : gt;
      const int c8 = (int)(i & 15), h = (int)((i >> 4) % 6), tok = (int)((i >> 4) / 6);
      const int b = tok >> 13, q = tok & (SEQ - 1), bh = b * 6 + h;
      ns[k] = min(q >> 8, 3);
      oo[k] = (size_t)tok * AW + h * 128 + c8 * 8;
      const size_t poff = ((size_t)bh * SEQ + q) * 128 + c8 * 8, loff = (size_t)bh * SEQ + q;
      vo[k] = *(const u32x4*)(OA + oo[k]); vg[k] = *(const u32x4*)(GA + oo[k]);
      v0[k] = *(const u32x4*)(P0 + poff); v1[k] = *(const u32x4*)(P1 + poff); v2[k] = *(const u32x4*)(P2 + poff);
      l4[k] = L4[loff];
    }
#pragma unroll
    for (int k = 0; k < 4; ++k) {
      if (base + k * NGT < N) {
        const bool s0 = ns[k] > 0, s1 = ns[k] > 1, s2 = ns[k] > 2;
        const u32x4 a = vo[k], b0 = v0[k], b1 = v1[k], b2 = v2[k], g = vg[k];
        float acc[8] = {bf_lo(a.x), bf_hi(a.x), bf_lo(a.y), bf_hi(a.y), bf_lo(a.z), bf_hi(a.z), bf_lo(a.w), bf_hi(a.w)};
        const float f0[8] = {bf_lo(b0.x), bf_hi(b0.x), bf_lo(b0.y), bf_hi(b0.y), bf_lo(b0.z), bf_hi(b0.z), bf_lo(b0.w), bf_hi(b0.w)};
        const float f1[8] = {bf_lo(b1.x), bf_hi(b1.x), bf_lo(b1.y), bf_hi(b1.y), bf_lo(b1.z), bf_hi(b1.z), bf_lo(b1.w), bf_hi(b1.w)};
        const float f2[8] = {bf_lo(b2.x), bf_hi(b2.x), bf_lo(b2.y), bf_hi(b2.y), bf_lo(b2.z), bf_hi(b2.z), bf_lo(b2.w), bf_hi(b2.w)};
#pragma unroll
        for (int e = 0; e < 8; ++e) acc[e] += (s0 ? f0[e] : 0.f) + (s1 ? f1[e] : 0.f) + (s2 ? f2[e] : 0.f);
        const float l = l4[k][3] + (s0 ? l4[k][0] : 0.f) + (s1 ? l4[k][1] : 0.f) + (s2 ? l4[k][2] : 0.f);
        const float inv = __builtin_amdgcn_rcpf(l);
        u32x4 o;
        o.x = pk2(acc[0] * inv * bf_lo(g.x), acc[1] * inv * bf_hi(g.x)); o.y = pk2(acc[2] * inv * bf_lo(g.y), acc[3] * inv * bf_hi(g.y));
        o.z = pk2(acc[4] * inv * bf_lo(g.z), acc[5] * inv * bf_hi(g.z)); o.w = pk2(acc[6] * inv * bf_lo(g.w), acc[7] * inv * bf_hi(g.w));
        *(u32x4*)(OA + oo[k]) = o;
      }
    }
  }
}

DI void xattn_pair(const int tid_, const Params& p, LAS char* lds, int bhd, int qt0) {
  char* ws = p.ws;
  const int tid = launder(tid_);
  const int w = tid >> 6, lane = tid & 63, r = lane & 31, hh = lane >> 5;
  const int hd = bhd & 3, b = bhd >> 2;
  __syncthreads();
  stage_kv_block(tid, (const bf16_t*)(ws + OFF_MEMK) + (size_t)bhd * 8 * 4096, (const bf16_t*)(ws + OFF_MEMVT) + (size_t)bhd * 8 * 4096, lds);
  __syncthreads();
  const float kmaxn = sqrtf(((const float*)(ws + OFF_MKMAX2))[bhd]);
#pragma unroll 1
  for (int i = 0; i < 2; ++i) {
    const int tok = b * SEQ + (qt0 + i) * 256 + 32 * w + r;
    bf16x8 qf[8];
    {
      const bf16_t* qrow = (const bf16_t*)(ws + OFF_QC) + (size_t)tok * CW + hd * 128 + 8 * hh;
#pragma unroll
      for (int ks = 0; ks < 8; ++ks) qf[ks] = *(const bf16x8*)(qrow + 16 * ks);
    }
    const float cs = sqrtf(qf_norm2(qf)) * kmaxn * ATT_SC;
    f32x16 o[4]; float ls = 0.f;
#pragma unroll
    for (int dt = 0; dt < 4; ++dt)
#pragma unroll
      for (int k = 0; k < 16; ++k) o[dt][k] = 0.f;
    attn_unit_lds<false>(qf, (const LAS bf16_t*)(lds + MB_K) + lane * 8, (const LAS bf16_t*)(lds + MB_V) + lane * 8, 8, cs, 1 << 30, hh, o, ls);
    ls += __shfl_xor(ls, 32);
    const float inv = __builtin_amdgcn_rcpf(ls);
    const bf16_t* gc = (const bf16_t*)(ws + OFF_GC) + (size_t)tok * CW + hd * 128 + 8 * hh;
    bf16_t* oc = (bf16_t*)((char*)p.out + DO_OC) + (size_t)tok * CW + hd * 128 + 8 * hh;
#pragma unroll
    for (int dt = 0; dt < 4; ++dt)
#pragma unroll
      for (int i4 = 0; i4 < 4; i4 += 2) {
        u32x2 ga, gb; unwiden32_pair(*(const u32x4*)(gc + dt * 32 + 8 * i4), ga, gb);
        f32x4 v, u;
        v[0] = o[dt][4 * i4 + 0] * inv * bf_lo(ga.x); v[1] = o[dt][4 * i4 + 1] * inv * bf_hi(ga.x);
        v[2] = o[dt][4 * i4 + 2] * inv * bf_lo(ga.y); v[3] = o[dt][4 * i4 + 3] * inv * bf_hi(ga.y);
        u[0] = o[dt][4 * i4 + 4] * inv * bf_lo(gb.x); u[1] = o[dt][4 * i4 + 5] * inv * bf_hi(gb.x);
        u[2] = o[dt][4 * i4 + 6] * inv * bf_lo(gb.y); u[3] = o[dt][4 * i4 + 7] * inv * bf_hi(gb.y);
        *(u32x4*)(oc + dt * 32 + 8 * i4) = widen32_pair(pk4(v), pk4(u));
      }
  }
}
DI void xattn_item(const int tid, const Params& p, int item) {
  char* ws = p.ws;
  const int w = tid >> 6, lane = tid & 63, r = lane & 31, hh = lane >> 5;
  const int qt = item & 31, bhd = item >> 5, hd = bhd & 3, b = bhd >> 2;
  const int tok = b * SEQ + qt * 256 + 32 * w + r;
  bf16x8 qf[8];
  {
    const bf16_t* qrow = (const bf16_t*)(ws + OFF_QC) + (size_t)tok * CW + hd * 128 + 8 * hh;
#pragma unroll
    for (int ks = 0; ks < 8; ++ks) qf[ks] = *(const bf16x8*)(qrow + 16 * ks);
  }
  const float kmaxn = sqrtf(((const float*)(ws + OFF_MKMAX2))[b * 4 + hd]);
  const float cs = sqrtf(qf_norm2(qf)) * kmaxn * ATT_SC;
  f32x16 o[4]; float ls = 0.f;
#pragma unroll
  for (int dt = 0; dt < 4; ++dt)
#pragma unroll
    for (int i = 0; i < 16; ++i) o[dt][i] = 0.f;
  const size_t boff = (size_t)bhd * 8 * 4096 + lane * 8;
  attn_unit(qf, (const bf16_t*)(ws + OFF_MEMK) + boff, (const bf16_t*)(ws + OFF_MEMVT) + boff, 8, cs, 1 << 30, hh, o, ls);
  ls += __shfl_xor(ls, 32);
  const float inv = 1.f / ls;
  const bf16_t* gc = (const bf16_t*)(ws + OFF_GC) + (size_t)tok * CW + hd * 128 + 4 * hh;
  bf16_t* oc = (bf16_t*)((char*)p.out + DO_OC) + (size_t)tok * CW + hd * 128 + 4 * hh;
#pragma unroll
  for (int dt = 0; dt < 4; ++dt)
#pragma unroll
    for (int i4 = 0; i4 < 4; ++i4) {
      const u32x2 g = *(const u32x2*)(gc + dt * 32 + 8 * i4);
      f32x4 v;
      v[0] = o[dt][4 * i4 + 0] * inv * bf_lo(g.x); v[1] = o[dt][4 * i4 + 1] * inv * bf_hi(g.x);
      v[2] = o[dt][4 * i4 + 2] * inv * bf_lo(g.y); v[3] = o[dt][4 * i4 + 3] * inv * bf_hi(g.y);
      st4(oc + dt * 32 + 8 * i4, v);
    }
}

DI void phase3a(const Params& p, LAS char* lds, const int wv) {
  const int tid = make_tid(wv);
  if (gridDim.x == 256) {
    const int xcd = blockIdx.x & 7, slot = blockIdx.x >> 3;
    for (int i = 0; i < 3; ++i) {
      const int bh = i * 8 + xcd;
      const int ob = (i == 0) ? slot : (i == 1 ? 31 - slot : ((slot + 16) & 31));
      moba_a_item(tid, p, lds, bh * 32 + ob);
    }
    xattn_pair(tid, p, lds, blockIdx.x >> 4, (blockIdx.x & 15) * 2);
  } else {
    for (int it = blockIdx.x; it < 768 + 512; it += gridDim.x) {
      if (it < 768) moba_a_item(tid, p, lds, it);
      else xattn_item(tid, p, it - 768);
    }
  }
}

DI void tile45(int L, int& tt, int& ct) {
  const int G = gridDim.x, b = blockIdx.x;
  if (G == 256) { const int xcd = b & 7, slot = b >> 3; tt = xcd * 16 + 8 * L + (slot & 7); ct = slot >> 3; }
  else { const int t = L * G + b; tt = t >> 2; ct = t & 3; }
}
struct P4Ops { const bf16_t *A, *B; int ld, K; };
DI P4Ops p4_ops(const Params& p, int tok0, int col0, int s) {
  char* ws = p.ws; P4Ops o;
  if (s == 0) { o.A = (const bf16_t*)(ws + OFF_WA) + (size_t)col0 * AW; o.B = (const bf16_t*)((const char*)p.out + DO_OA) + (size_t)tok0 * AW; o.ld = AW; o.K = AW; }
  else if (s == 1) { o.A = (const bf16_t*)(ws + OFF_WB) + (size_t)col0 * AW; o.B = (const bf16_t*)((const char*)p.out + DO_OB) + (size_t)tok0 * AW; o.ld = AW; o.K = AW; }
  else if (s == 2) { o.A = (const bf16_t*)(ws + OFF_WC) + (size_t)col0 * CW; o.B = (const bf16_t*)((const char*)p.out + DO_OC) + (size_t)tok0 * CW; o.ld = CW; o.K = CW; }
  else { o.A = (const bf16_t*)(ws + OFF_WIN) + (size_t)(6400 + (s - 3) * 1024 + col0) * DM; o.B = (const bf16_t*)(ws + OFF_HB) + (size_t)tok0 * DM; o.ld = DM; o.K = DM; }
  return o;
}
DI void phase4(const Params& p, LAS char* lds, const int wv) {
  char* ws = p.ws;
  const int tid = make_tid(wv);
  const int nL = (gridDim.x == 256) ? 2 : (512 + gridDim.x - 1) / gridDim.x;
  int nvalid = 0;
  for (int L = 0; L < nL; ++L) { int tt, ct; tile45(L, tt, ct); if (tt < 128) nvalid = L + 1; }
  if (nvalid == 0) return;
  { int tt, ct; tile45(0, tt, ct); const P4Ops o = p4_ops(p, tt * 256, ct * 256, 0); gemm_begin(tid, o.A, o.B, o.ld, lds); }
#pragma unroll 1
  for (int u = 0; u < nvalid * 6; ++u) {
    const int L = u / 6, s = u - L * 6;
    int tt, ct; tile45(L, tt, ct);
    const int tok0 = tt * 256, col0 = ct * 256;
    const P4Ops o = p4_ops(p, tok0, col0, s);
    const int un = (u + 1 < nvalid * 6) ? u + 1 : u, Ln = un / 6, sn = un - Ln * 6;
    int t2, c2; tile45(Ln, t2, c2);
    const P4Ops nx = p4_ops(p, t2 * 256, c2 * 256, sn);
    f32x4 acc[2][2][4][2];
    gemm_unit(tid, o.A, o.B, o.ld, o.K, nx.A, nx.B, nx.ld, lds, acc);
    if (s < 3) epi_rowmajor(tid, acc, (bf16_t*)(ws + (s == 0 ? OFF_TA : (s == 1 ? OFF_TB : OFF_TC))), DM, tok0, col0, EP_PLAIN, nullptr);
    else epi_gate(tid, acc, (const bf16_t*)(ws + (s == 3 ? OFF_TA : (s == 4 ? OFF_TB : OFF_TC))), (bf16_t*)(ws + OFF_Y), tok0, col0, s == 3);
  }
  gemm_end(tid);
}
DI void phase5(const Params& p, LAS char* lds, const int wv, float* rowss) {
  char* ws = p.ws;
  const int tid = make_tid(wv);
  const int nL = (gridDim.x == 256) ? 2 : (512 + gridDim.x - 1) / gridDim.x;
  int nvalid = 0;
  for (int L = 0; L < nL; ++L) { int tt, ct; tile45(L, tt, ct); if (tt < 128) nvalid = L + 1; }
  if (nvalid == 0) return;
  const bf16_t* WO = (const bf16_t*)(ws + OFF_WO); const bf16_t* Y = (const bf16_t*)(ws + OFF_Y);
  if (tid == 0) *(LAS unsigned*)(lds + 131072 + 8192) = 0u;
  { int tt, ct; tile45(0, tt, ct); gemm_begin(tid, WO + (size_t)ct * 256 * DM, Y + (size_t)tt * 256 * DM, DM, lds); }
#pragma unroll 1
  for (int L = 0; L < nvalid; ++L) {
    int tt, ct; tile45(L, tt, ct);
    int t2, c2; tile45((L + 1 < nvalid) ? L + 1 : L, t2, c2);
    f32x4 acc[2][2][4][2];
    gemm_unit(tid, WO + (size_t)ct * 256 * DM, Y + (size_t)tt * 256 * DM, DM, DM, WO + (size_t)c2 * 256 * DM, Y + (size_t)t2 * 256 * DM, DM, lds, acc);
    const int wr5 = __builtin_amdgcn_readfirstlane(tid >> 8);
    if (wr5 == 0) G_BAR;
    epi_out_norm(tid, acc, p.x, p.out, rowss, (unsigned*)(ws + OFF_C5) + tt, p.final_g, tt * 256, ct * 256, (LAS unsigned*)(lds + 131072 + 8192));
    if (wr5 == 1) G_BAR;
  }
  gemm_end(tid);
}
DI void phase6(const Params& p, const int wv) {
  const size_t gt = (size_t)blockIdx.x * NTHREADS + make_tid(wv), NGT = (size_t)gridDim.x * NTHREADS;
  const float* rowss = (const float*)(p.ws + OFF_ROWSS);
  const size_t N = (size_t)MTOK * (DM / 4);
  f32x4* out4 = (f32x4*)p.out;
  for (size_t base = gt; base < N; base += NGT * 8) {
    f32x4 z[8]; float ss[8];
#pragma unroll
    for (int k = 0; k < 8; ++k) { const size_t i = base + k * NGT; const size_t ic = i < N ? i : gt; z[k] = out4[ic]; ss[k] = rowss[ic >> 8]; }
#pragma unroll
    for (int k = 0; k < 8; ++k) {
      const size_t i = base + k * NGT;
      if (i < N) {
        const float rs = rsqrtf(ss[k] * (1.f / DM) + 1e-6f);
        const f32x4 g = ((const f32x4*)p.final_g)[i & 255];
        f32x4 o; o[0] = z[k][0] * rs * g[0]; o[1] = z[k][1] * rs * g[1]; o[2] = z[k][2] * rs * g[2]; o[3] = z[k][3] * rs * g[3];
        out4[i] = o;
      }
    }
  }
}

__global__ void __launch_bounds__(NTHREADS) fwd_megakernel(Params p) {
  extern __shared__ __attribute__((aligned(16))) char smem_raw[];
  LAS char* lds = (LAS char*)smem_raw;
  cg::grid_group grid = cg::this_grid();
  const int wv = __builtin_amdgcn_readfirstlane((int)threadIdx.x >> 6);
  for (int rep = 0; rep < REP0; ++rep) phase0(p, lds, wv);
  grid.sync();
  unsigned* bar = (unsigned*)(p.ws + OFF_BAR);
  const unsigned G = gridDim.x;
  for (int rep = 0; rep < REP1; ++rep) phase1(p, lds, wv);
  grid_bar(bar, 1u, make_tid(wv));
  for (int rep = 0; rep < REP2; ++rep) phase2(p, lds, wv);
  grid_bar(bar, 2u, make_tid(wv));
  phase3a(p, lds, wv);
  grid_bar(bar, 3u, make_tid(wv));
  for (int rep = 0; rep < REP3; ++rep) phase3b(p, lds, wv);
  grid_bar(bar, 4u, make_tid(wv));
  phase3c(p, wv);
  grid_bar(bar, 5u, make_tid(wv));
  for (int rep = 0; rep < REP4; ++rep) phase4(p, lds, wv);
  grid_bar(bar, 6u, make_tid(wv));
  phase5(p, lds, wv, (float*)(p.ws + OFF_ROWSS));
}

extern "C" void kernel_launch(void* const* d_in, const int* in_sizes, int n_in,
                              void* d_out, int out_size, void* d_ws, size_t ws_size,
                              hipStream_t stream) {
  static int grid_blocks = 0;
  if (!grid_blocks) {
    int dev = 0, cus = 0, per_cu = 0;
    (void)hipGetDevice(&dev);
    (void)hipDeviceGetAttribute(&cus, hipDeviceAttributeMultiprocessorCount, dev);
    (void)hipFuncSetAttribute((const void*)fwd_megakernel, hipFuncAttributeMaxDynamicSharedMemorySize, LDS_BYTES);
    (void)hipOccupancyMaxActiveBlocksPerMultiprocessor(&per_cu, (const void*)fwd_megakernel, NTHREADS, LDS_BYTES);
    if (per_cu < 1) per_cu = 1;
    grid_blocks = cus * per_cu;
    if (ws_size < WS_END3) fprintf(stderr, "kernel_launch: workspace too small: %zu < %zu\n", ws_size, (size_t)WS_END3);
  }
  Params p{};
  p.x = (const float*)d_in[0]; p.mem = (const float*)d_in[1]; p.norm_g = (const float*)d_in[2]; p.mem_norm_g = (const float*)d_in[3];
  p.final_g = (const float*)d_in[4]; p.w_in = (const float*)d_in[5]; p.w_mkv = (const float*)d_in[6]; p.ln_g = (const float*)d_in[7];
  p.w_sp = (const float*)d_in[8]; p.b_sp = (const float*)d_in[9]; p.w_a = (const float*)d_in[10]; p.w_b = (const float*)d_in[11];
  p.w_c = (const float*)d_in[12]; p.w_out = (const float*)d_in[13];
  p.out = (float*)d_out; p.ws = (char*)d_ws;
  void* args[] = {&p};
  hipError_t e = hipLaunchCooperativeKernel((void*)fwd_megakernel, dim3(grid_blocks), dim3(NTHREADS), args, LDS_BYTES, stream);
  if (e != hipSuccess) fprintf(stderr, "cooperative launch failed: %s (grid %d)\n", hipGetErrorString(e), grid_blocks);
}
```
